# Optimizing an MI355X kernel written in HIP

```python
import math
import jax, jax.numpy as jnp
from jax import lax
import numpy as np

D_MODEL = 2048
BATCH = 4
SEQ = 2048
DEPTH = 4
DEC_BATCH = 128
DEC_SEQ = 8
PAST_LEN = 16384
PAGE_SIZE = 128

N_AB = (DEPTH + 1) // 2
N_C = DEPTH // 2
HEAD = 64
W_A = D_MODEL // 2
H_A = W_A // HEAD
LORA_W = 64
LORA_A = 64
LORA_G = 160
COLS_A = 3 * W_A + LORA_W + LORA_A + LORA_G
W_B = D_MODEL // 2
N_BLK_B = W_B // HEAD
CONV_W = 4
LRU_C = 8.0
COLS_AB = COLS_A + 2 * W_B
W_C = D_MODEL
GRP_C = 16
N_GRP_C = W_C // GRP_C
P_C = 64
D_FF = 5632
D_PLE = 256
RMS_EPS = 1e-6
GN_EPS = 64e-5

kernel_name = 'hybrid_rwkv7_rglru_s5_step'


def rmsnorm(x, g):
    xf = x.astype(jnp.float32)
    y = xf * lax.rsqrt(jnp.mean(xf * xf, axis=-1, keepdims=True) + RMS_EPS)
    return (y * g.astype(jnp.float32)).astype(x.dtype)


def swiglu(h, wg, wu, wd):
    return (jax.nn.silu(h @ wg) * (h @ wu)) @ wd


def _linear_combine(e1, e2):
    a1, b1 = e1
    a2, b2 = e2
    return (a1 * a2, a2 * b1 + b2)


def _complex_linear_combine(e1, e2):
    a1r, a1i, b1r, b1i = e1
    a2r, a2i, b2r, b2i = e2
    return (a2r * a1r - a2i * a1i, a2r * a1i + a2i * a1r,
            a2r * b1r - a2i * b1i + b2r, a2r * b1i + a2i * b1r + b2i)


def rwkv7_mix(za, shift_prev, wkv0, mu, w0, w2, a0, a2, g2, k_k, k_a, r_k, lnx_g, lnx_b):
    f32 = jnp.float32
    bsz, t = za.shape[0], za.shape[1]
    za = za.astype(f32)
    zprev = jnp.concatenate([shift_prev[:, None, :].astype(f32), za[:, :-1]], axis=1)
    zs = za + (zprev - za) * mu.astype(f32)
    r, k, v, xw, xa, xg = jnp.split(
        zs, [W_A, 2 * W_A, 3 * W_A, 3 * W_A + LORA_W, 3 * W_A + LORA_W + LORA_A], axis=-1)
    w_log = -jax.nn.softplus(-(w0 + jnp.tanh(xw) @ w2)) - 0.5
    decay = jnp.exp(-jnp.exp(w_log))
    a = jax.nn.sigmoid(a0 + xa @ a2)
    g = jax.nn.sigmoid(xg) @ g2
    kk = k * k_k
    k = k * (1.0 + (a - 1.0) * k_a)
    heads = lambda u: u.reshape(bsz, t, H_A, HEAD)
    kk = heads(kk)
    kk = kk / jnp.maximum(jnp.sqrt(jnp.sum(kk * kk, axis=-1, keepdims=True)), 1e-12)
    r, k, v, decay, a = heads(r), heads(k), heads(v), heads(decay), heads(a)

    def step(S, inp):
        r_t, w_t, k_t, v_t, kk_t, a_t = inp
        sa = jnp.einsum('bhij,bhj->bhi', S, -kk_t)
        S = (S * w_t[:, :, None, :] + sa[..., None] * (kk_t * a_t)[:, :, None, :]
             + v_t[..., None] * k_t[:, :, None, :])
        return S, jnp.einsum('bhij,bhj->bhi', S, r_t)

    tmaj = lambda u: jnp.swapaxes(u, 0, 1)
    s_last, y = lax.scan(step, wkv0.astype(f32), tuple(tmaj(u) for u in (r, decay, k, v, kk, a)))
    y = tmaj(y)
    mu_y = jnp.mean(y, axis=-1, keepdims=True)
    var = jnp.mean(jnp.square(y - mu_y), axis=-1, keepdims=True)
    yn = ((y - mu_y) * lax.rsqrt(var + GN_EPS)).reshape(bsz, t, W_A) * lnx_g + lnx_b
    bonus = (jnp.sum(r * k * r_k, axis=-1, keepdims=True) * v).reshape(bsz, t, W_A)
    return (yn + bonus) * g, s_last, za[:, -1]


def rglru_mix(xb, gb, h0, conv_buf, conv_w, conv_b, wa, ba, wx, bx, lam):
    f32 = jnp.float32
    bsz, t = xb.shape[0], xb.shape[1]
    xpad = jnp.concatenate([conv_buf.astype(f32), xb.astype(f32)], axis=1)
    xc = conv_b.astype(f32)
    for j in range(CONV_W):
        xc = xc + xpad[:, j:j + t] * conv_w[j]
    blk = xc.reshape(bsz, t, N_BLK_B, HEAD)
    gate_r = jax.nn.sigmoid(jnp.einsum('btnh,nhk->btnk', blk, wa).reshape(bsz, t, W_B) + ba)
    gate_i = jax.nn.sigmoid(jnp.einsum('btnh,nhk->btnk', blk, wx).reshape(bsz, t, W_B) + bx)
    log_a = -LRU_C * gate_r * jax.nn.softplus(-lam)
    a = jnp.exp(log_a)
    b = jnp.sqrt(-jnp.expm1(2.0 * log_a)) * (gate_i * xc)
    b = b.at[:, 0].add(a[:, 0] * h0.astype(f32))
    _, h = lax.associative_scan(_linear_combine, (a, b), axis=1)
    y = h * jax.nn.gelu(gb.astype(f32))
    return y, h[:, -1], xpad[:, xpad.shape[1] - (CONV_W - 1):]


def s5_mix(u, h0_re, h0_im, a_re, a_im, log_dt, b_re, b_im, c_re, c_im, d_skip, w_glu, b_glu):
    f32 = jnp.float32
    bsz, t = u.shape[0], u.shape[1]
    uf = u.astype(f32)
    ug = uf.reshape(bsz, t, N_GRP_C, GRP_C)
    a_re = a_re.astype(f32)
    a_im = a_im.astype(f32)
    dt = jnp.exp(log_dt.astype(f32))[:, None]
    mag = jnp.exp(dt * a_re)
    ab_re, ab_im = mag * jnp.cos(dt * a_im), mag * jnp.sin(dt * a_im)
    den = a_re * a_re + a_im * a_im
    f_re = ((ab_re - 1.0) * a_re + ab_im * a_im) / den
    f_im = (ab_im * a_re - (ab_re - 1.0) * a_im) / den
    bb_re = f_re[..., None] * b_re - f_im[..., None] * b_im
    bb_im = f_re[..., None] * b_im + f_im[..., None] * b_re
    bu_re = jnp.einsum('btgc,gpc->btgp', ug, bb_re)
    bu_im = jnp.einsum('btgc,gpc->btgp', ug, bb_im)
    h0_re = h0_re.astype(f32)
    h0_im = h0_im.astype(f32)
    bu_re = bu_re.at[:, 0].add(ab_re * h0_re - ab_im * h0_im)
    bu_im = bu_im.at[:, 0].add(ab_re * h0_im + ab_im * h0_re)
    shp = (1, t, N_GRP_C, P_C)
    _, _, h_re, h_im = lax.associative_scan(
        _complex_linear_combine,
        (jnp.broadcast_to(ab_re, shp), jnp.broadcast_to(ab_im, shp), bu_re, bu_im), axis=1)
    y = (jnp.einsum('btgp,gcp->btgc', h_re, c_re)
         - jnp.einsum('btgp,gcp->btgc', h_im, c_im)).reshape(bsz, t, W_C) + d_skip * uf
    z = jax.nn.gelu(y)
    return z * jax.nn.sigmoid(z @ w_glu + b_glu), h_re[:, -1], h_im[:, -1]


def trunk(x, p, st_wkv, st_shift, st_h, st_conv, st_cre, st_cim, w):
    new_wkv, new_shift, new_h, new_conv, new_cre, new_cim = [], [], [], [], [], []
    for l in range(DEPTH):
        j = l // 2
        x = x + 0.5 * swiglu(rmsnorm(x, w['norm_ffn1'][l]), w['ffn1_wg'][l], w['ffn1_wu'][l], w['ffn1_wd'][l])
        hmix = rmsnorm(x, w['norm_mix'][l])
        if l % 2 == 0:
            z = hmix @ w['w_in_ab'][j]
            za, zbx, zbg = jnp.split(z, [COLS_A, COLS_A + W_B], axis=-1)
            ya, s_wkv, s_shift = rwkv7_mix(
                za, st_shift[j], st_wkv[j], w['mu_a'][j], w['w0_a'][j], w['w2_a'][j], w['a0_a'][j],
                w['a2_a'][j], w['g2_a'][j], w['kk_a'][j], w['ka_a'][j], w['rk_a'][j],
                w['lnx_g'][j], w['lnx_b'][j])
            yb, s_h, s_conv = rglru_mix(
                zbx, zbg, st_h[j], st_conv[j], w['conv_w_b'][j], w['conv_b_b'][j], w['wa_b'][j],
                w['ba_b'][j], w['wx_b'][j], w['bx_b'][j], w['lam_b'][j])
            x = x + jnp.concatenate([ya, yb], axis=-1).astype(x.dtype) @ w['w_out_ab'][j]
            new_wkv.append(s_wkv)
            new_shift.append(s_shift)
            new_h.append(s_h)
            new_conv.append(s_conv)
        else:
            yc, s_re, s_im = s5_mix(
                hmix, st_cre[j], st_cim[j], w['a_re_c'][j], w['a_im_c'][j], w['log_dt_c'][j],
                w['b_re_c'][j], w['b_im_c'][j], w['c_re_c'][j], w['c_im_c'][j], w['d_c'][j],
                w['w_glu_c'][j], w['b_glu_c'][j])
            x = x + yc.astype(x.dtype)
            new_cre.append(s_re)
            new_cim.append(s_im)
        x = x + 0.5 * swiglu(rmsnorm(x, w['norm_ffn2'][l]), w['ffn2_wg'][l], w['ffn2_wu'][l], w['ffn2_wd'][l])
        gate = jax.nn.sigmoid(rmsnorm(x, w['norm_ple'][l]) @ w['ple_gate'][l])
        x = x + gate * (p[l] @ w['ple_proj'][l])
    y = rmsnorm(x, w['final_norm'])
    stk = lambda lst, ref: jnp.stack(lst).astype(ref.dtype)
    return y, (stk(new_wkv, st_wkv), stk(new_shift, st_shift), stk(new_h, st_h),
               stk(new_conv, st_conv), stk(new_cre, st_cre), stk(new_cim, st_cim))


def setup_inputs(seed: int = 0) -> dict:
    key = jax.random.key(seed)
    keys = jax.random.split(key, 96)
    counter = [0]
    f32 = jnp.float32

    def nk():
        k = keys[counter[0]]
        counter[0] += 1
        return k

    nrm = lambda shape, scale: jax.random.normal(nk(), shape, f32) * scale
    gain = lambda shape: 1.0 + 0.01 * jax.random.normal(nk(), shape, f32)
    unif = lambda shape, lo, hi: jax.random.uniform(nk(), shape, f32, lo, hi)

    d = {}
    d['x_prompt'] = nrm((BATCH, SEQ, D_MODEL), 1.0)
    d['x_sample'] = nrm((DEC_BATCH, DEC_SEQ, D_MODEL), 1.0)
    d['state_a_wkv'] = nrm((N_AB, DEC_BATCH, H_A, HEAD, HEAD), 0.5)
    d['state_a_shift'] = nrm((N_AB, DEC_BATCH, COLS_A), 1.0)
    d['state_b_h'] = nrm((N_AB, DEC_BATCH, W_B), 0.5)
    d['state_b_conv'] = nrm((N_AB, DEC_BATCH, CONV_W - 1, W_B), 1.0)
    d['state_c_re'] = nrm((N_C, DEC_BATCH, N_GRP_C, P_C), 0.1)
    d['state_c_im'] = nrm((N_C, DEC_BATCH, N_GRP_C, P_C), 0.1)
    d['p_prompt'] = nrm((DEPTH, BATCH, SEQ, D_PLE), 1.0)
    d['p_sample'] = nrm((DEPTH, DEC_BATCH, DEC_SEQ, D_PLE), 1.0)
    d['norm_ffn1'] = gain((DEPTH, D_MODEL))
    d['ffn1_wg'] = nrm((DEPTH, D_MODEL, D_FF), D_MODEL ** -0.5)
    d['ffn1_wu'] = nrm((DEPTH, D_MODEL, D_FF), D_MODEL ** -0.5)
    d['ffn1_wd'] = nrm((DEPTH, D_FF, D_MODEL), D_FF ** -0.5)
    d['norm_mix'] = gain((DEPTH, D_MODEL))
    d['norm_ffn2'] = gain((DEPTH, D_MODEL))
    d['ffn2_wg'] = nrm((DEPTH, D_MODEL, D_FF), D_MODEL ** -0.5)
    d['ffn2_wu'] = nrm((DEPTH, D_MODEL, D_FF), D_MODEL ** -0.5)
    d['ffn2_wd'] = nrm((DEPTH, D_FF, D_MODEL), D_FF ** -0.5)
    d['norm_ple'] = gain((DEPTH, D_MODEL))
    d['ple_gate'] = nrm((DEPTH, D_MODEL, D_MODEL), D_MODEL ** -0.5)
    d['ple_proj'] = nrm((DEPTH, D_PLE, D_MODEL), D_PLE ** -0.5)
    d['w_in_ab'] = nrm((N_AB, D_MODEL, COLS_AB), D_MODEL ** -0.5)
    d['mu_a'] = unif((N_AB, COLS_A), 0.0, 1.0)
    ramp = jnp.arange(W_A, dtype=f32) / (W_A - 1)
    d['w0_a'] = (-6.5 + 5.0 * ramp)[None, :] + nrm((N_AB, W_A), 0.1)
    d['w2_a'] = nrm((N_AB, LORA_W, W_A), 0.1 * LORA_W ** -0.5)
    d['a0_a'] = nrm((N_AB, W_A), 0.1)
    d['a2_a'] = nrm((N_AB, LORA_A, W_A), LORA_A ** -0.5)
    d['g2_a'] = nrm((N_AB, LORA_G, W_A), LORA_G ** -0.5)
    d['kk_a'] = 0.85 + nrm((N_AB, W_A), 0.02)
    d['ka_a'] = 1.0 + nrm((N_AB, W_A), 0.02)
    d['rk_a'] = nrm((N_AB, H_A, HEAD), 0.1)
    d['lnx_g'] = gain((N_AB, W_A))
    d['lnx_b'] = nrm((N_AB, W_A), 0.01)
    d['conv_w_b'] = nrm((N_AB, CONV_W, W_B), CONV_W ** -0.5)
    d['conv_b_b'] = nrm((N_AB, W_B), 0.01)
    d['wa_b'] = nrm((N_AB, N_BLK_B, HEAD, HEAD), HEAD ** -0.5)
    d['ba_b'] = nrm((N_AB, W_B), 0.01)
    d['wx_b'] = nrm((N_AB, N_BLK_B, HEAD, HEAD), HEAD ** -0.5)
    d['bx_b'] = nrm((N_AB, W_B), 0.01)
    a_pow = unif((N_AB, W_B), 0.9, 0.999) ** (1.0 / LRU_C)
    d['lam_b'] = jnp.log(a_pow) - jnp.log1p(-a_pow)
    d['w_out_ab'] = nrm((N_AB, W_A + W_B, D_MODEL), (W_A + W_B) ** -0.5)
    d['a_re_c'] = -0.5 * jnp.exp(nrm((N_C, N_GRP_C, P_C), 0.05))
    d['a_im_c'] = math.pi * jnp.arange(P_C, dtype=f32)[None, None, :] + nrm((N_C, N_GRP_C, P_C), 0.01)
    d['log_dt_c'] = unif((N_C, N_GRP_C), math.log(1e-3), math.log(1e-1))
    d['b_re_c'] = nrm((N_C, N_GRP_C, P_C, GRP_C), (2 * GRP_C) ** -0.5)
    d['b_im_c'] = nrm((N_C, N_GRP_C, P_C, GRP_C), (2 * GRP_C) ** -0.5)
    d['c_re_c'] = nrm((N_C, N_GRP_C, GRP_C, P_C), P_C ** -0.5)
    d['c_im_c'] = nrm((N_C, N_GRP_C, GRP_C, P_C), P_C ** -0.5)
    d['d_c'] = nrm((N_C, W_C), 1.0)
    d['w_glu_c'] = nrm((N_C, W_C, W_C), W_C ** -0.5)
    d['b_glu_c'] = nrm((N_C, W_C), 0.01)
    d['final_norm'] = gain((D_MODEL,))
    return d


def reference(x_prompt, x_sample, state_a_wkv, state_a_shift, state_b_h, state_b_conv,
              state_c_re, state_c_im, p_prompt, p_sample,
              norm_ffn1, ffn1_wg, ffn1_wu, ffn1_wd, norm_mix, norm_ffn2, ffn2_wg, ffn2_wu, ffn2_wd,
              norm_ple, ple_gate, ple_proj,
              w_in_ab, mu_a, w0_a, w2_a, a0_a, a2_a, g2_a, kk_a, ka_a, rk_a, lnx_g, lnx_b,
              conv_w_b, conv_b_b, wa_b, ba_b, wx_b, bx_b, lam_b, w_out_ab,
              a_re_c, a_im_c, log_dt_c, b_re_c, b_im_c, c_re_c, c_im_c, d_c, w_glu_c, b_glu_c,
              final_norm):
    w = dict(norm_ffn1=norm_ffn1, ffn1_wg=ffn1_wg, ffn1_wu=ffn1_wu, ffn1_wd=ffn1_wd,
             norm_mix=norm_mix, norm_ffn2=norm_ffn2, ffn2_wg=ffn2_wg, ffn2_wu=ffn2_wu,
             ffn2_wd=ffn2_wd, norm_ple=norm_ple, ple_gate=ple_gate, ple_proj=ple_proj,
             w_in_ab=w_in_ab, mu_a=mu_a, w0_a=w0_a, w2_a=w2_a, a0_a=a0_a, a2_a=a2_a, g2_a=g2_a,
             kk_a=kk_a, ka_a=ka_a, rk_a=rk_a, lnx_g=lnx_g, lnx_b=lnx_b,
             conv_w_b=conv_w_b, conv_b_b=conv_b_b, wa_b=wa_b, ba_b=ba_b, wx_b=wx_b, bx_b=bx_b,
             lam_b=lam_b, w_out_ab=w_out_ab,
             a_re_c=a_re_c, a_im_c=a_im_c, log_dt_c=log_dt_c, b_re_c=b_re_c, b_im_c=b_im_c,
             c_re_c=c_re_c, c_im_c=c_im_c, d_c=d_c, w_glu_c=w_glu_c, b_glu_c=b_glu_c,
             final_norm=final_norm)
    bp = x_prompt.shape[0]
    z_wkv = jnp.zeros((N_AB, bp, H_A, HEAD, HEAD), state_a_wkv.dtype)
    z_shift = jnp.zeros((N_AB, bp, COLS_A), state_a_shift.dtype)
    z_h = jnp.zeros((N_AB, bp, W_B), state_b_h.dtype)
    z_conv = jnp.zeros((N_AB, bp, CONV_W - 1, W_B), state_b_conv.dtype)
    z_cre = jnp.zeros((N_C, bp, N_GRP_C, P_C), state_c_re.dtype)
    z_cim = jnp.zeros((N_C, bp, N_GRP_C, P_C), state_c_im.dtype)
    y_prompt, (pw, ps, ph, pc, pre, pim) = trunk(
        x_prompt, p_prompt, z_wkv, z_shift, z_h, z_conv, z_cre, z_cim, w)
    y_sample, (sw, ss, sh, sc, sre, sim) = trunk(
        x_sample, p_sample, state_a_wkv, state_a_shift, state_b_h, state_b_conv,
        state_c_re, state_c_im, w)
    return (y_prompt, y_sample, pw, ps, ph, pc, pre, pim, sw, ss, sh, sc, sre, sim)
```

```cpp
#include <hip/hip_runtime.h>
#include <cstdio>
#include <cstdint>
namespace pg8 {
#define PG8_LAS __attribute__((address_space(3)))
typedef unsigned short bf16_t;
typedef short bf16x8 __attribute__((ext_vector_type(8)));
typedef float f32x4 __attribute__((ext_vector_type(4)));
typedef unsigned u32x4 __attribute__((ext_vector_type(4)));
constexpr int BM = 256, BK = 64, HALF = 128, HTB = HALF * BK * 2  , STAGE_BYTES = 8 * HTB, NXCD = 8, WGM = 8;

__host__ __device__ __forceinline__ int lds_byte(int r, int c) { const int st = (r >> 4) * 2 + (c >> 5), rr = r & 15, cc = c & 31, ob = rr * 64 + cc * 2; return st * 1024 + (ob ^ (((ob >> 9) & 1) << 5)); }
__host__ __device__ __forceinline__ void stage_rc(int b, int& R, int& C) { const int st = b / 1024, sb = b % 1024, swz = sb ^ (((sb >> 9) & 1) << 5); R = (st >> 1) * 16 + swz / 64; C = (st & 1) * 32 + (swz % 64) / 2; }
__host__ __device__ __forceinline__ int perm32(int rho) { const int n = rho >> 4, i = rho & 15; return 8 * (i >> 2) + 4 * n + (i & 3); }

struct Unit { int pm, pn; };
struct Gemm { const bf16_t* A; const bf16_t* Bt; int M, N, K; };

struct StaticOrder {
    int nM, nN, nwg, G, c;
    __host__ __device__ void init(int M, int N, int G_, int c_) { nM = M / BM; nN = N / BM; nwg = nM * nN; G = G_; c = c_; }
    __host__ __device__ bool next(int i, Unit& u) const {
        const long L = (long)i * G + c; if (L >= nwg) return false;
        int wgid = (int)L; { const int q = nwg / NXCD, r = nwg % NXCD, xcd = wgid % NXCD, off = wgid / NXCD; wgid = (xcd < r ? xcd * (q + 1) : r * (q + 1) + (xcd - r) * q) + off; }
        const int nig = WGM * nN, gid = wgid / nig, fm = gid * WGM, gsz = (nM - fm) < WGM ? (nM - fm) : WGM;
        u.pm = fm + ((wgid % nig) % gsz); u.pn = (wgid % nig) / gsz; return true;
    }
    __device__ __forceinline__ void a_ready(const Unit&) const {}
    __device__ __forceinline__ void done(const Unit&) const {}
};

__device__ __forceinline__ unsigned cvt_pk_bf16(float lo, float hi) { unsigned r; asm volatile("v_cvt_pk_bf16_f32 %0, %1, %2" : "=v"(r) : "v"(lo), "v"(hi)); return r; }
typedef float f32x2 __attribute__((ext_vector_type(2)));
constexpr float RMS_EPS_F = 1e-6f, INV_D = 1.0f / 2048.0f;
__device__ __forceinline__ float rstd_of(const float* ssq, int row) { return __builtin_amdgcn_rsqf(ssq[row] * INV_D + RMS_EPS_F); }
__device__ __forceinline__ float sigm(float x) { return __builtin_amdgcn_rcpf(1.0f + __builtin_amdgcn_exp2f(-1.44269504f * x)); }
typedef unsigned u32x2 __attribute__((ext_vector_type(2)));
struct EpiF32 {
    static constexpr bool PERM = false, AFTER_DRAIN = false;
    float* C; int ldc; const float* ssq;
    __device__ __forceinline__ void operator()(const f32x4 (&acc)[2][2][4][2], const Unit& u, int wr, int wc, int fr, int fq) const {
        const int row0 = u.pm * BM + wr * 64 + fr, col0 = u.pn * BM + wc * 32 + 4 * fq;
#pragma unroll
        for (int ai = 0; ai < 2; ++ai)
#pragma unroll
            for (int m = 0; m < 4; ++m) { const int row = row0 + ai * HALF + m * 16; const float rs = ssq ? rstd_of(ssq, row) : 1.0f; float* rowp = C + (size_t)row * ldc + col0;
#pragma unroll
                for (int bj = 0; bj < 2; ++bj)
#pragma unroll
                    for (int n = 0; n < 2; ++n) *(f32x4*)(rowp + bj * HALF + n * 16) = acc[ai][bj][m][n] * rs; }
    }
};
struct EpiSwiGLU {
    static constexpr bool PERM = true, AFTER_DRAIN = false;
    bf16_t* H; int ldh; const float* ssq;
    __device__ __forceinline__ void operator()(const f32x4 (&acc)[2][2][4][2], const Unit& u, int wr, int wc, int fr, int fq) const {
        const int row0 = u.pm * BM + wr * 64 + fr, col0 = u.pn * HALF + wc * 32 + 8 * fq;
#pragma unroll
        for (int ai = 0; ai < 2; ++ai)
#pragma unroll
            for (int m = 0; m < 4; ++m) { const int row = row0 + ai * HALF + m * 16; const float rs = rstd_of(ssq, row); u32x4 w;
#pragma unroll
                for (int n = 0; n < 2; ++n) { const f32x4 g = acc[ai][0][m][n] * rs, uu = acc[ai][1][m][n] * rs; f32x4 h;
#pragma unroll
                    for (int e = 0; e < 4; ++e) h[e] = g[e] * uu[e] * sigm(g[e]);
                    w[2 * n] = cvt_pk_bf16(h[0], h[1]); w[2 * n + 1] = cvt_pk_bf16(h[2], h[3]); }
                *(u32x4*)(H + (size_t)row * ldh + col0) = w; }
    }
};
template <int MODE> struct EpiRes {
    static constexpr bool PERM = false, AFTER_DRAIN = false;
    float* X; bf16_t* XB; float* ssq_out; float scale; const float* ssq_in; const float* PP; const bf16_t* ZG; const float* bias;
    __device__ __forceinline__ void operator()(const f32x4 (&acc)[2][2][4][2], const Unit& u, int wr, int wc, int fr, int fq) const {
        const int row0 = u.pm * BM + wr * 64 + fr, col0 = u.pn * BM + wc * 32 + 4 * fq;
#pragma unroll
        for (int ai = 0; ai < 2; ++ai)
#pragma unroll
            for (int m = 0; m < 4; ++m) { const int row = row0 + ai * HALF + m * 16; const size_t off = (size_t)row * 2048 + col0; float s = 0.f;
                const float rs = (MODE == 1) ? rstd_of(ssq_in, row) : 1.0f;
#pragma unroll
                for (int bj = 0; bj < 2; ++bj)
#pragma unroll
                    for (int n = 0; n < 2; ++n) { const size_t o = off + bj * HALF + n * 16; const f32x4 xv = *(const f32x4*)(X + o); f32x4 d;
                        if (MODE == 0) d = acc[ai][bj][m][n] * scale;
                        if (MODE == 1) { const f32x4 pp = *(const f32x4*)(PP + o); const f32x4 a = acc[ai][bj][m][n] * rs;
#pragma unroll
                            for (int e = 0; e < 4; ++e) d[e] = sigm(a[e]) * pp[e]; }
                        if (MODE == 2) { const u32x2 zz = *(const u32x2*)(ZG + o); const f32x4 bv = *(const f32x4*)(bias + col0 + bj * HALF + n * 16); const f32x4 a = acc[ai][bj][m][n] + bv;
                            f32x4 z; z[0] = __uint_as_float(zz[0] << 16); z[1] = __uint_as_float(zz[0] & 0xffff0000u); z[2] = __uint_as_float(zz[1] << 16); z[3] = __uint_as_float(zz[1] & 0xffff0000u);
#pragma unroll
                            for (int e = 0; e < 4; ++e) d[e] = z[e] * sigm(a[e]); }
                        const f32x4 xn = xv + d; *(f32x4*)(X + o) = xn; u32x2 w; w[0] = cvt_pk_bf16(xn[0], xn[1]); w[1] = cvt_pk_bf16(xn[2], xn[3]); *(u32x2*)(XB + o) = w;
                        s += (xn[0] * xn[0] + xn[1] * xn[1]) + (xn[2] * xn[2] + xn[3] * xn[3]); }
                s += __shfl_xor(s, 16); s += __shfl_xor(s, 32);
                if (fq == 0) __hip_atomic_fetch_add(ssq_out + row, s, __ATOMIC_RELAXED, __HIP_MEMORY_SCOPE_AGENT); }
    }
};
template <class Epi, class Sched, bool ALIGN_EPI = false, bool SP2 = false>
__device__ __forceinline__ void gemm_phase(PG8_LAS unsigned char* lds, const Gemm g, const Sched& S, const Epi& E) {
    int tid_ = threadIdx.x; asm volatile("" : "+v"(tid_));
    const int tid = tid_, wid = __builtin_amdgcn_readfirstlane(tid >> 6), lane = tid & 63, wr = wid >> 2, wc = wid & 3, fr = lane & 15, fq = lane >> 4;
    const int K = g.K, nt = K / BK;
    unsigned voffA[2], voffB[2];
#pragma unroll
    for (int i = 0; i < 2; ++i) { int R, C; stage_rc(tid * 16 + i * 8192, R, C); const int Rb = Epi::PERM ? ((R & ~31) + perm32(R & 31)) : R;
        voffA[i] = (unsigned)(R * K + C) * 2u; voffB[i] = (unsigned)(Rb * K + C) * 2u; }
    const size_t kstep = (size_t)(BK * 2);
    const size_t hstep = (size_t)HALF * K * 2;
    const size_t tstep = 2 * hstep;
    const unsigned ldsw = (unsigned)wid * 1024u;
    const int aoff = lds_byte(wr * 64 + fr, fq * 8), boff = lds_byte(wc * 32 + fr, fq * 8);
#define PG8_SA(b, h) (((b) * 2 + (h)) * HTB)
#define PG8_SB(b, h) ((4 + (b) * 2 + (h)) * HTB)
#define PG8_STAGE(bufoff, gbase, voff) do { _Pragma("unroll") for (int _i = 0; _i < 2; ++_i) \
        __builtin_amdgcn_global_load_lds((const unsigned*)((const char*)(gbase) + (voff)[_i]), (PG8_LAS unsigned*)(lds + (bufoff) + ldsw + _i * 8192), 16, 0, 0); } while (0)
#define PG8_LDA(dst, b, h) do { _Pragma("unroll") for (int m = 0; m < 4; ++m) _Pragma("unroll") for (int k = 0; k < 2; ++k) dst[m][k] = *(const PG8_LAS bf16x8*)(lds + PG8_SA(b, h) + aoff + m * 2048 + k * 1024); } while (0)
#define PG8_LDB(dst, b, h) do { _Pragma("unroll") for (int n = 0; n < 2; ++n) _Pragma("unroll") for (int k = 0; k < 2; ++k) dst[n][k] = *(const PG8_LAS bf16x8*)(lds + PG8_SB(b, h) + boff + n * 2048 + k * 1024); } while (0)
#define PG8_MMA(ai, bj, At, Bt) do { __builtin_amdgcn_s_setprio(1); _Pragma("unroll") for (int m = 0; m < 4; ++m) _Pragma("unroll") for (int n = 0; n < 2; ++n) _Pragma("unroll") for (int k = 0; k < 2; ++k) \
        acc[ai][bj][m][n] = __builtin_amdgcn_mfma_f32_16x16x32_bf16(Bt[n][k], At[m][k], acc[ai][bj][m][n], 0, 0, 0); __builtin_amdgcn_s_setprio(0); } while (0)
#define PG8_WAIT_V(n) asm volatile("s_waitcnt vmcnt(" #n ")" ::: "memory")
#define PG8_WAIT_L(n) asm volatile("s_waitcnt lgkmcnt(" #n ")" ::: "memory")
#define PG8_BAR __builtin_amdgcn_s_barrier()
#define PG8_SCHED __builtin_amdgcn_sched_barrier(0)
    Unit cur, nxt; int ui = 0;
    if (!S.next(0, cur)) return;
    f32x4 acc[2][2][4][2];
#pragma unroll
    for (int a = 0; a < 2; ++a)
#pragma unroll
        for (int b = 0; b < 2; ++b)
#pragma unroll
            for (int m = 0; m < 4; ++m)
#pragma unroll
                for (int n = 0; n < 2; ++n) acc[a][b][m][n] = (f32x4){0.f, 0.f, 0.f, 0.f};
    bf16x8 At[4][2], B0[2][2], B1[2][2];
    const char* cA = (const char*)g.A + (size_t)cur.pm * tstep; const char* cB = (const char*)g.Bt + (size_t)cur.pn * tstep;
    S.a_ready(cur);
    if constexpr (SP2) {
        PG8_STAGE(PG8_SB(0, 0), cB, voffB); PG8_STAGE(PG8_SB(0, 1), cB + hstep, voffB); PG8_STAGE(PG8_SA(0, 0), cA, voffA); PG8_STAGE(PG8_SA(0, 1), cA + hstep, voffA);
        if (wr == 1) PG8_BAR;
        PG8_WAIT_V(2); PG8_BAR;
        PG8_STAGE(PG8_SB(1, 0), cB + kstep, voffB); PG8_STAGE(PG8_SA(1, 0), cA + kstep, voffA); PG8_STAGE(PG8_SB(1, 1), cB + hstep + kstep, voffB);
        PG8_WAIT_V(6); PG8_BAR;
    } else {
        PG8_STAGE(PG8_SB(0, 0), cB, voffB); PG8_STAGE(PG8_SA(0, 0), cA, voffA); PG8_STAGE(PG8_SB(0, 1), cB + hstep, voffB); PG8_STAGE(PG8_SA(0, 1), cA + hstep, voffA);
        if (wr == 1) PG8_BAR;
        PG8_WAIT_V(4); PG8_BAR;
        PG8_STAGE(PG8_SB(1, 0), cB + kstep, voffB); PG8_STAGE(PG8_SA(1, 0), cA + kstep, voffA); PG8_STAGE(PG8_SB(1, 1), cB + hstep + kstep, voffB);
        PG8_WAIT_V(6); PG8_BAR;
    }
    for (;;) {
        const bool has_next = S.next(ui + 1, nxt);
        const char* nA = has_next ? (const char*)g.A + (size_t)nxt.pm * tstep : cA; const char* nB = has_next ? (const char*)g.Bt + (size_t)nxt.pn * tstep : cB;
        for (int t = 0; t < nt; t += 2) {
            const bool last = (t == nt - 2);
            const char* a1 = cA + (size_t)(t + 1) * kstep;
            const char* a2 = last ? nA : cA + (size_t)(t + 2) * kstep; const char* b2 = last ? nB : cB + (size_t)(t + 2) * kstep;
            const char* a3 = a2 + kstep; const char* b3 = b2 + kstep;
            if (last && has_next) S.a_ready(nxt);
            if constexpr (SP2) {
            PG8_LDB(B0, 0, 0); PG8_LDB(B1, 0, 1); PG8_SCHED; PG8_LDA(At, 0, 0); PG8_STAGE(PG8_SA(1, 1), a1 + hstep, voffA);
            PG8_WAIT_V(8); PG8_WAIT_L(0); PG8_BAR; PG8_MMA(0, 0, At, B0); PG8_MMA(0, 1, At, B1); PG8_BAR; PG8_SCHED;
            PG8_LDA(At, 0, 1); PG8_STAGE(PG8_SB(0, 0), b2, voffB); PG8_STAGE(PG8_SB(0, 1), b2 + hstep, voffB); PG8_STAGE(PG8_SA(0, 0), a2, voffA);
            PG8_WAIT_V(8); PG8_WAIT_L(0); PG8_BAR; PG8_MMA(1, 0, At, B0); PG8_MMA(1, 1, At, B1); PG8_BAR; PG8_SCHED;
            PG8_LDB(B0, 1, 0); PG8_LDB(B1, 1, 1); PG8_SCHED; PG8_LDA(At, 1, 0); PG8_STAGE(PG8_SA(0, 1), a2 + hstep, voffA);
            PG8_WAIT_V(8); PG8_WAIT_L(0); PG8_BAR; PG8_MMA(0, 0, At, B0); PG8_MMA(0, 1, At, B1); PG8_BAR; PG8_SCHED;
            PG8_LDA(At, 1, 1); PG8_STAGE(PG8_SB(1, 0), b3, voffB); PG8_STAGE(PG8_SB(1, 1), b3 + hstep, voffB); PG8_STAGE(PG8_SA(1, 0), a3, voffA);
            PG8_WAIT_V(8); PG8_WAIT_L(0); PG8_BAR; PG8_MMA(1, 0, At, B0); PG8_MMA(1, 1, At, B1); PG8_BAR; PG8_SCHED;
            } else {
            PG8_LDB(B0, 0, 0); PG8_SCHED; PG8_LDA(At, 0, 0); PG8_STAGE(PG8_SA(1, 1), a1 + hstep, voffA);
            PG8_WAIT_L(8); PG8_BAR; PG8_WAIT_L(0); PG8_MMA(0, 0, At, B0); PG8_BAR; PG8_SCHED;
            PG8_LDB(B1, 0, 1); PG8_STAGE(PG8_SB(0, 0), b2, voffB);
            PG8_BAR; PG8_WAIT_L(0); PG8_MMA(0, 1, At, B1); PG8_BAR;
            PG8_LDA(At, 0, 1); PG8_STAGE(PG8_SA(0, 0), a2, voffA);
            PG8_BAR; PG8_WAIT_L(0); PG8_MMA(1, 0, At, B0); PG8_BAR; PG8_SCHED;
            PG8_STAGE(PG8_SB(0, 1), b2 + hstep, voffB);
            PG8_WAIT_V(6); PG8_BAR; PG8_MMA(1, 1, At, B1); PG8_BAR;
            PG8_LDB(B0, 1, 0); PG8_SCHED; PG8_LDA(At, 1, 0); PG8_STAGE(PG8_SA(0, 1), a2 + hstep, voffA);
            PG8_WAIT_L(8); PG8_BAR; PG8_WAIT_L(0); PG8_MMA(0, 0, At, B0); PG8_BAR; PG8_SCHED;
            PG8_LDB(B1, 1, 1); PG8_STAGE(PG8_SB(1, 0), b3, voffB);
            PG8_BAR; PG8_WAIT_L(0); PG8_MMA(0, 1, At, B1); PG8_BAR;
            PG8_LDA(At, 1, 1); PG8_STAGE(PG8_SA(1, 0), a3, voffA);
            PG8_BAR; PG8_WAIT_L(0); PG8_MMA(1, 0, At, B0); PG8_BAR; PG8_SCHED;
            PG8_STAGE(PG8_SB(1, 1), b3 + hstep, voffB);
            PG8_WAIT_V(6); PG8_BAR; PG8_MMA(1, 1, At, B1); PG8_BAR;
            }
        }
        if constexpr (ALIGN_EPI) { if (wr == 0) PG8_BAR; }
        if constexpr (!Epi::AFTER_DRAIN) { E(acc, cur, wr, wc, fr, fq); S.done(cur); }
        if (!has_next) break;
#pragma unroll
        for (int a = 0; a < 2; ++a)
#pragma unroll
            for (int b = 0; b < 2; ++b)
#pragma unroll
                for (int m = 0; m < 4; ++m)
#pragma unroll
                    for (int n = 0; n < 2; ++n) acc[a][b][m][n] = (f32x4){0.f, 0.f, 0.f, 0.f};
        cur = nxt; cA = nA; cB = nB; ++ui;
        if constexpr (ALIGN_EPI) { if (wr == 1) PG8_BAR; }
    }
    PG8_WAIT_V(0);
    if constexpr (!ALIGN_EPI) { if (wr == 0) PG8_BAR; }
    PG8_BAR;
    if constexpr (Epi::AFTER_DRAIN) { E.fused(acc, cur, wr, wc, fr, fq, lds, wid, lane); S.done(cur); }
#undef PG8_SA
#undef PG8_SB
#undef PG8_STAGE
#undef PG8_LDA
#undef PG8_LDB
#undef PG8_MMA
#undef PG8_WAIT_V
#undef PG8_WAIT_L
#undef PG8_BAR
#undef PG8_SCHED
}
}
constexpr int NWAVES = 8;
constexpr int M = 9216, MPR = 8192, D = 2048, FF = 5632, NGU = 11264, ZP = 5632, COLSA = 3360, TP = 2048, TS = 8, NBS = 128, NBP = 4;
constexpr int NSITE = 17;
constexpr float GN_EPS = 64e-5f;
constexpr size_t MiB = 1u << 20;
constexpr size_t WS_CTL = 0, CTL_ZERO_BYTES = 2 * MiB;
constexpr size_t WS_SSQ = 1 * MiB;
constexpr size_t WS_WGU = 2 * MiB, SZ_WGU = (size_t)NGU * D * 2;
constexpr size_t WS_WD = WS_WGU + 8 * SZ_WGU, SZ_WD = (size_t)D * FF * 2;
constexpr size_t WS_PLEG = WS_WD + 8 * SZ_WD, SZ_SQ = (size_t)D * D * 2;
constexpr size_t WS_PLEP = WS_PLEG + 4 * SZ_SQ, SZ_PLEP = (size_t)D * 256 * 2;
constexpr size_t WS_WIN = WS_PLEP + 4 * SZ_PLEP, SZ_WIN = (size_t)ZP * D * 2;
constexpr size_t WS_WOUT = WS_WIN + 2 * SZ_WIN;
constexpr size_t WS_WGLU = WS_WOUT + 2 * SZ_SQ;
constexpr size_t WS_WLORA = WS_WGLU + 2 * SZ_SQ, SZ_WLORA = (size_t)3072 * 384 * 2;
constexpr size_t WS_WGATE = WS_WLORA + 2 * SZ_WLORA, SZ_WGATE = (size_t)2048 * 1024 * 2;
constexpr size_t WS_S5AB = WS_WGATE + 2 * SZ_WGATE;
constexpr size_t WS_S5BUB = WS_S5AB + 256 * 1024, SZ_BUB = (size_t)128 * 8 * 64 * 16;
constexpr size_t WS_S5CB = WS_S5BUB + 2 * SZ_BUB, SZ_CB = (size_t)128 * 4 * 64 * 16;
constexpr size_t WS_S5DG = WS_S5CB + 2 * SZ_CB;
constexpr size_t WS_X = (WS_S5DG + 16384 + MiB - 1) / MiB * MiB;
constexpr size_t WS_XB = WS_X + (size_t)M * D * 4;
constexpr size_t WS_PB = WS_XB + (size_t)2 * M * D * 2;
constexpr size_t WS_AR = WS_PB + (size_t)4 * M * 256 * 2;
constexpr size_t AR_Z = 0;
constexpr size_t AR_A2 = AR_Z + (size_t)M * ZP * 4;
constexpr size_t AR_XCB = AR_A2 + (size_t)M * 384 * 2;
constexpr size_t AR_L = AR_XCB + (size_t)M * 1024 * 2;
constexpr size_t AR_GT = AR_L + (size_t)M * 3072 * 4;
constexpr size_t AR_RW = AR_GT + (size_t)M * 2048 * 4;
constexpr size_t AR_BON = AR_RW + (size_t)M * 16 * 384 * 4;
constexpr size_t AR_END = AR_BON + (size_t)M * 16 * 4;
constexpr size_t AR_HID = 0;
constexpr size_t AR_Y = 0;
constexpr size_t AR_YMIX = AR_Y + (size_t)M * 1024 * 4;
constexpr size_t AR_PPT = 0;
constexpr size_t AR_ZG = 0;
constexpr size_t WS_END = WS_AR + AR_END;
static_assert(AR_YMIX + (size_t)M * 2048 * 2 <= AR_A2, "Y/YMIX overlay inside Z");
constexpr int CW_TMO = 0, CW_BAR = 4096;
constexpr size_t O_Y = 0, O_P_WKV = 18874368, O_P_SHIFT = 19398656, O_P_H = 19425536, O_P_CONV = 19433728, O_P_CRE = 19458304, O_P_CIM = 19523840,
                 O_S_WKV = 19589376, O_S_SHIFT = 36366592, O_S_H = 37226752, O_S_CONV = 37488896, O_S_CRE = 38275328, O_S_CIM = 40372480, O_END = 42469632;
constexpr int RING_OFF = 0, RING_BYTES = 131072;
constexpr int LDSCTL_OFF = RING_BYTES, MISC_OFF = LDSCTL_OFF + 320;
constexpr int LDS_BYTES = 147456;
#define GAS __attribute__((address_space(1)))
#define LAS __attribute__((address_space(3)))
#define DI __device__ __forceinline__
typedef unsigned short bf16;
typedef unsigned v4u __attribute__((ext_vector_type(4)));
typedef unsigned v2u __attribute__((ext_vector_type(2)));
typedef float f32x4 __attribute__((ext_vector_type(4)));
typedef float f32x2 __attribute__((ext_vector_type(2)));
typedef short bf16x8 __attribute__((ext_vector_type(8)));
typedef GAS unsigned gu32;
#define RLX_AGENT __ATOMIC_RELAXED, __HIP_MEMORY_SCOPE_AGENT
#define LDS_WAIT() asm volatile("s_waitcnt lgkmcnt(0)" ::: "memory")
#define VM_WAIT() asm volatile("s_waitcnt vmcnt(0)" ::: "memory")
DI unsigned f2bf(float f) { unsigned u = __builtin_bit_cast(unsigned, f); return (u + 0x7fffu + ((u >> 16) & 1u)) >> 16; }
DI unsigned pk2(float lo, float hi) { return f2bf(lo) | (f2bf(hi) << 16); }
DI float bf_lo(unsigned w) { return __uint_as_float(w << 16); }
DI float bf_hi(unsigned w) { return __uint_as_float(w & 0xffff0000u); }
DI float wave_sum(float v) {
#pragma unroll
    for (int o = 1; o < 64; o <<= 1) v += __shfl_xor(v, o);
    return v;
}
template <int CTRL> DI float dpp_mov(float v) { return __builtin_bit_cast(float, __builtin_amdgcn_update_dpp(0, __builtin_bit_cast(int, v), CTRL, 0xf, 0xf, true)); }
DI float sum16(float s) {
    s += dpp_mov<0xB1>(s); s += dpp_mov<0x4E>(s); s += dpp_mov<0x141>(s); s += dpp_mov<0x140>(s); return s;
}
DI float sigmoid_acc(float x) { return 1.0f / (1.0f + expf(-x)); }
DI float gelu_tanh(float x) { const float z = 1.5957691216f * (x + 0.044715f * x * x * x); return x / (1.0f + __expf(-z)); }
DI float softplus_acc(float x) { return x > 20.f ? x : log1pf(expf(x)); }
#define XB_TMO      128
#define XB_XCNT(j)  (256  + 64 * (j))
#define XB_XSUB(j)  (1280 + 64 * (j))
#define XB_XGEN(j)  (2304 + 64 * (j))
#define XB_TOP      3328
#define XB_TOPGEN   3392
#define XCD_BAR_WORDS 3456
#define XB_SPIN_CAP (1u << 18)

__device__ __forceinline__ unsigned xb_ld(unsigned* p)              { return __hip_atomic_load(p, __ATOMIC_RELAXED, __HIP_MEMORY_SCOPE_AGENT); }
__device__ __forceinline__ unsigned xb_add(unsigned* p, unsigned v) { return __hip_atomic_fetch_add(p, v, __ATOMIC_RELAXED, __HIP_MEMORY_SCOPE_AGENT); }
__device__ __forceinline__ unsigned xb_xcc_id() { return (unsigned)__builtin_amdgcn_s_getreg((3 << 11) | 20) & 0xFu; }
#define XB_SPIN(cond, bar) do { unsigned _sp = 0; while (cond) { __builtin_amdgcn_s_sleep(1); \
    if ((++_sp & 255u) == 0u) { if (xb_ld(&(bar)[XB_TMO])) break; if (_sp > XB_SPIN_CAP) { atomicAdd(&(bar)[XB_TMO], 1u); break; } } } } while (0)

struct XcdBarrier {
    unsigned* bar; unsigned x;
    volatile LAS unsigned* st;
};

__device__ __forceinline__ XcdBarrier xcd_barrier_post(unsigned* bar, volatile LAS unsigned* st) {
    XcdBarrier b; b.bar = bar; b.x = xb_xcc_id(); b.st = st;
    if (threadIdx.x == 0) (void)xb_add(&bar[XB_XCNT(b.x)], 1u);
    return b;
}
__device__ __forceinline__ void xcd_barrier_complete(unsigned* bar, unsigned x, unsigned& nloc, unsigned& nx) {
    const unsigned G = gridDim.x * gridDim.y * gridDim.z;
    unsigned sum, cnt, mine, sp = 0u;
    for (;;) {
        sum = 0u; cnt = 0u; mine = 0u;
#pragma unroll
        for (unsigned j = 0; j < 16; ++j) { const unsigned c = xb_ld(&bar[XB_XCNT(j)]); sum += c; cnt += (c > 0u) ? 1u : 0u; mine = (j == x) ? c : mine; }
        if (sum == G) break;
        __builtin_amdgcn_s_sleep(1);
        if ((++sp & 255u) == 0u) { if (xb_ld(&bar[XB_TMO])) break; if (sp > XB_SPIN_CAP) { atomicAdd(&bar[XB_TMO], 1u); break; } }
    }
    nloc = mine > 0u ? mine : 1u; nx = cnt > 0u ? cnt : 1u;
}

__device__ __forceinline__ void xcd_barrier(const XcdBarrier& b) {
    asm volatile("s_waitcnt vmcnt(0)" ::: "memory");
    __syncthreads();
    if (threadIdx.x == 0) {
        unsigned* bar = b.bar;
        __builtin_amdgcn_s_waitcnt(0);
        unsigned nloc = b.st[0], nx = b.st[1];
        if (nloc == 0u) { xcd_barrier_complete(bar, b.x, nloc, nx); b.st[0] = nloc; b.st[1] = nx; }
        const unsigned old = xb_add(&bar[XB_XSUB(b.x)], 1u);
        const unsigned gen = old / nloc;
        if (old + 1u == (gen + 1u) * nloc) {
            __builtin_amdgcn_fence(__ATOMIC_RELEASE, "agent");
            asm volatile("s_waitcnt vmcnt(0)" ::: "memory");
            const unsigned og = xb_add(&bar[XB_TOP], 1u);
            const unsigned tg = og / nx;
            if (og + 1u == (tg + 1u) * nx) xb_add(&bar[XB_TOPGEN], 1u);
            else XB_SPIN(xb_ld(&bar[XB_TOPGEN]) == tg, bar);
            __builtin_amdgcn_fence(__ATOMIC_ACQUIRE, "agent");
            xb_add(&bar[XB_XGEN(b.x)], 1u);
            asm volatile("s_waitcnt vmcnt(0)" ::: "memory");
        } else {
            XB_SPIN(xb_ld(&bar[XB_XGEN(b.x)]) == gen, bar);
            __builtin_amdgcn_fence(__ATOMIC_ACQUIRE, "agent");
            asm volatile("s_waitcnt vmcnt(0)" ::: "memory");
        }
    }
    __syncthreads();
}
struct Args { const float* in[53]; float* out; unsigned char* ws; };
struct KArgsT { const GAS float* in_[53]; GAS float* out_; GAS unsigned char* ws_; };
typedef const __attribute__((address_space(4))) KArgsT* KA;
#define INP(k) ((const float*)a->in_[k])
#define OUTP ((float*)a->out_)
#define WSP ((unsigned char*)a->ws_)
#define FRESH(p) asm volatile("" : "+s"(p))
struct Frame {
    LAS unsigned char* lds;
    volatile LAS unsigned* MISC;
    gu32* ctl;
    int tid, lane, wave, vcu, G, gw, NGW;
};
DI void refresh(Frame& F) { int t = threadIdx.x; asm volatile("" : "+v"(t)); F.tid = t; F.lane = t & 63; F.wave = __builtin_amdgcn_readfirstlane(t >> 6); F.gw = F.vcu * NWAVES + F.wave; }

DI void tr_item(const float* W, int ldw, int k0, int n0, bf16* WT, int dstK, int drow0, const float* ksc, LAS float* scr, int lane) {
#pragma unroll 8
    for (int i = 0; i < 32; ++i) { const int kk = 2 * i + (lane >> 5); float v = W[(size_t)(k0 + kk) * ldw + n0 + (lane & 31)]; if (ksc) v *= ksc[k0 + kk]; scr[kk * 33 + (lane & 31)] = v; }
    LDS_WAIT(); asm volatile("" ::: "memory");
    const int c = lane & 7;
#pragma unroll
    for (int j = 0; j < 4; ++j) { const int n = (lane >> 3) + 8 * j; const LAS float* s = scr + (8 * c) * 33 + n;
        v4u o; o.x = pk2(s[0 * 33], s[1 * 33]); o.y = pk2(s[2 * 33], s[3 * 33]); o.z = pk2(s[4 * 33], s[5 * 33]); o.w = pk2(s[6 * 33], s[7 * 33]);
        *(v4u*)(WT + (size_t)(drow0 + n) * dstK + k0 + 8 * c) = o; }
    LDS_WAIT(); asm volatile("" ::: "memory");
}
DI void s5_coef(KA a, int j, int g, int p, float& abr, float& abi, float& fr, float& fi) {
    const int ix = (j * 128 + g) * 64 + p; const float are = INP(42)[ix], aim = INP(43)[ix], dt = expf(INP(44)[j * 128 + g]);
    const float mag = expf(dt * are); abr = mag * cosf(dt * aim); abi = mag * sinf(dt * aim);
    const float den = are * are + aim * aim; fr = ((abr - 1.0f) * are + abi * aim) / den; fi = (abi * are - (abr - 1.0f) * aim) / den;
}
DI void p0_prologue(KA a, Frame& F) {
    unsigned char* ws = WSP;
    LAS float* scr = (LAS float*)(F.lds + RING_OFF + F.wave * 16384);
    constexpr int NA = 16 * 5632, NB = 8 * 5632, NC = 8 * 2048, ND = 2 * 5408, NE = 4 * 256, NIT = NA + NB + NC + ND + NE;
    for (int it = F.gw; it < NIT; it += F.NGW) {
        int r = it; const float* W; const float* ksc = nullptr; bf16* dst; int ldw, k0, n0, dstK, drow0;
        if (r < NA) { const int mtx = r / 5632, rr = r % 5632, lf = mtx >> 1, gu = mtx & 1, l = lf >> 1, f = lf & 1, kb = rr / 176, nb = rr % 176;
            const float* src = f ? (gu ? INP(17) : INP(16)) : (gu ? INP(12) : INP(11));
            W = src + (size_t)l * D * FF; ldw = FF; k0 = kb * 64; n0 = nb * 32; dst = (bf16*)(ws + WS_WGU + (size_t)lf * SZ_WGU); dstK = D; drow0 = (n0 >> 7) * 256 + (n0 & 127) + gu * 128 - n0;
            ksc = (f ? INP(15) : INP(10)) + l * D; }
        else if ((r -= NA) < NB) { const int mtx = r / 5632, rr = r % 5632, l = mtx >> 1, f = mtx & 1, kb = rr / 64, nb = rr % 64;
            W = (f ? INP(18) : INP(13)) + (size_t)l * FF * D; ldw = D; k0 = kb * 64; n0 = nb * 32; dst = (bf16*)(ws + WS_WD + (size_t)mtx * SZ_WD); dstK = FF; drow0 = 0; }
        else if ((r -= NB) < NC) { const int mtx = r / 2048, rr = r % 2048, kb = rr / 64, nb = rr % 64;
            if (mtx < 4) { W = INP(20) + (size_t)mtx * D * D; dst = (bf16*)(ws + WS_PLEG + (size_t)mtx * SZ_SQ); ksc = INP(19) + mtx * D; }
            else if (mtx < 6) { W = INP(41) + (size_t)(mtx - 4) * D * D; dst = (bf16*)(ws + WS_WOUT + (size_t)(mtx - 4) * SZ_SQ); }
            else { W = INP(50) + (size_t)(mtx - 6) * D * D; dst = (bf16*)(ws + WS_WGLU + (size_t)(mtx - 6) * SZ_SQ); }
            ldw = D; k0 = kb * 64; n0 = nb * 32; dstK = D; drow0 = 0; }
        else if ((r -= NC) < ND) { const int j = r / 5408, rr = r % 5408, kb = rr / 169, nb = rr % 169;
            W = INP(22) + (size_t)j * D * 5408; ldw = 5408; k0 = kb * 64; n0 = nb * 32; dst = (bf16*)(ws + WS_WIN + (size_t)j * SZ_WIN); dstK = D; drow0 = 0; ksc = INP(14) + (2 * j) * D; }
        else { r -= ND; const int l = r / 256, rr = r % 256, kb = rr / 64, nb = rr % 64;
            W = INP(21) + (size_t)l * 256 * D; ldw = D; k0 = kb * 64; n0 = nb * 32; dst = (bf16*)(ws + WS_PLEP + (size_t)l * SZ_PLEP); dstK = 256; drow0 = 0; }
        tr_item(W, ldw, k0, n0, dst, dstK, n0 + drow0, ksc, scr, F.lane);
    }
    const int gt = F.gw * 64 + F.lane, NGT = F.NGW * 64;
    for (int i = gt; i < 2 * 224 * 256; i += NGT) { const int j = i / (224 * 256), r = i % (224 * 256); *(v4u*)(ws + WS_WIN + (size_t)j * SZ_WIN + ((size_t)5408 * D + (size_t)r * 8) * 2) = (v4u){0u, 0u, 0u, 0u}; }
    for (int i = gt; i < 2 * 3072 * 48; i += NGT) { const int j = i / (3072 * 48), r = i % (3072 * 48), n = r / 48, kv = (r % 48) * 8; float v[8];
#pragma unroll
        for (int e = 0; e < 8; ++e) { const int k = kv + e; float x = 0.f;
            if (n < 1024) { if (k < 64) x = INP(25)[((size_t)j * 64 + k) * 1024 + n]; }
            else if (n < 2048) { if (k >= 64 && k < 128) x = INP(27)[((size_t)j * 64 + (k - 64)) * 1024 + (n - 1024)]; }
            else { if (k >= 128 && k < 288) x = INP(28)[((size_t)j * 160 + (k - 128)) * 1024 + (n - 2048)]; }
            v[e] = x; }
        *(v4u*)(ws + WS_WLORA + (size_t)j * SZ_WLORA + ((size_t)n * 384 + kv) * 2) = (v4u){pk2(v[0], v[1]), pk2(v[2], v[3]), pk2(v[4], v[5]), pk2(v[6], v[7])}; }
    for (int i = gt; i < 2 * 2048 * 128; i += NGT) { const int j = i / (2048 * 128), r = i % (2048 * 128), n = r / 128, kv = (r % 128) * 8; const int blk = (n & 1023) >> 6, ko = n & 63; float v[8];
        const float* src = (n < 1024 ? INP(36) : INP(38)) + ((size_t)j * 16 + blk) * 4096;
#pragma unroll
        for (int e = 0; e < 8; ++e) { const int k = kv + e; v[e] = ((k >> 6) == blk) ? src[(k & 63) * 64 + ko] : 0.f; }
        *(v4u*)(ws + WS_WGATE + (size_t)j * SZ_WGATE + ((size_t)n * 1024 + kv) * 2) = (v4u){pk2(v[0], v[1]), pk2(v[2], v[3]), pk2(v[4], v[5]), pk2(v[6], v[7])}; }
    for (int i = gt; i < 2 * 128 * 64; i += NGT) { const int j = i / 8192, g = (i % 8192) / 64, p = i % 64; float abr, abi, fr, fi; s5_coef(a, j, g, p, abr, abi, fr, fi);
        *(f32x2*)(ws + WS_S5AB + (size_t)i * 8) = (f32x2){abr, abi}; }
    for (int i = gt; i < 2 * 128 * 8 * 64; i += NGT) { const int j = i / 65536, g = (i / 512) % 128, nb = (i / 64) % 8, ln = i % 64, n = nb * 16 + (ln & 15), p = n >> 1, part = n & 1, quad = ln >> 4; float v[8];
        float abr, abi, fr, fi; s5_coef(a, j, g, p, abr, abi, fr, fi);
#pragma unroll
        for (int e = 0; e < 8; ++e) { const int k = quad * 8 + e; float x = 0.f;
            if (k < 16) { const size_t ix = (((size_t)j * 128 + g) * 64 + p) * 16 + k; const float br = INP(45)[ix], bi = INP(46)[ix]; const float bb = part ? (fr * bi + fi * br) : (fr * br - fi * bi); x = bb * INP(14)[(2 * j + 1) * D + g * 16 + k]; }
            v[e] = x; }
        *(v4u*)(ws + WS_S5BUB + (size_t)i * 16) = (v4u){pk2(v[0], v[1]), pk2(v[2], v[3]), pk2(v[4], v[5]), pk2(v[6], v[7])}; }
    for (int i = gt; i < 2 * 128 * 4 * 64; i += NGT) { const int j = i / 32768, g = (i / 256) % 128, ks = (i / 64) % 4, ln = i % 64, c = ln & 15, quad = ln >> 4; float v[8];
#pragma unroll
        for (int e = 0; e < 8; ++e) { const int k = ks * 32 + quad * 8 + e, p = k >> 1, part = k & 1; const size_t ix = (((size_t)j * 128 + g) * 16 + c) * 64 + p; v[e] = part ? -INP(48)[ix] : INP(47)[ix]; }
        *(v4u*)(ws + WS_S5CB + (size_t)i * 16) = (v4u){pk2(v[0], v[1]), pk2(v[2], v[3]), pk2(v[4], v[5]), pk2(v[6], v[7])}; }
    for (int i = gt; i < 2 * 2048; i += NGT) { const int j = i / 2048, c = i % 2048; ((float*)(ws + WS_S5DG))[i] = INP(49)[i] * INP(14)[(2 * j + 1) * D + c]; }
    for (int i = gt; i < 4 * M * 32; i += NGT) { const int l = i / (M * 32), r = i % (M * 32), m = r / 32, kv = (r % 32) * 8;
        const float* src = (m < MPR) ? INP(8) + ((size_t)l * MPR + m) * 256 + kv : INP(9) + ((size_t)l * 1024 + (m - MPR)) * 256 + kv;
        const f32x4 x0 = *(const f32x4*)src, x1 = *(const f32x4*)(src + 4);
        *(v4u*)(ws + WS_PB + (size_t)i * 16) = (v4u){pk2(x0[0], x0[1]), pk2(x0[2], x0[3]), pk2(x1[0], x1[1]), pk2(x1[2], x1[3])}; }
    float* X = (float*)(ws + WS_X); bf16* XB = (bf16*)(ws + WS_XB); float* ssq = (float*)(ws + WS_SSQ);
    for (int m = F.gw; m < M; m += F.NGW) { const float* src = (m < MPR) ? INP(0) + (size_t)m * D : INP(1) + (size_t)(m - MPR) * D; float s = 0.f;
#pragma unroll
        for (int i = 0; i < 8; ++i) { const int c = F.lane * 4 + 256 * i; const f32x4 v = *(const f32x4*)(src + c); *(f32x4*)(X + (size_t)m * D + c) = v; *(v2u*)(XB + (size_t)m * D + c) = (v2u){pk2(v[0], v[1]), pk2(v[2], v[3])};
            s += (v[0] * v[0] + v[1] * v[1]) + (v[2] * v[2] + v[3] * v[3]); }
        s = wave_sum(s); if (F.lane == 0) ssq[m] = s; }
}
constexpr size_t RW_PROMPT = (size_t)64 * 2048 * 384;
DI size_t rw_off(bool smp, int b, int h, int t) { return smp ? RW_PROMPT + ((size_t)(b * 16 + h) * 8 + t) * 384 : ((size_t)(b * 16 + h) * 2048 + t) * 384; }
DI void mix_pass_a(KA a, Frame& F, int j) {
    unsigned char* ar = WSP + WS_AR; const float* Z = (const float*)(ar + AR_Z); bf16* A2 = (bf16*)(ar + AR_A2); bf16* XCB = (bf16*)(ar + AR_XCB);
    const float* mu = INP(23) + j * COLSA; const float* cw = INP(34) + j * 4096; const float* cb = INP(35) + j * 1024; const int lane = F.lane;
    for (int m = F.gw; m < M; m += F.NGW) {
        const bool smp = m >= MPR; const int b = smp ? (m - MPR) >> 3 : m >> 11, t = smp ? (m - MPR) & 7 : m & 2047, T = smp ? TS : TP;
        const float* zr = Z + (size_t)m * ZP; const float* zp = t > 0 ? zr - ZP : (smp ? INP(3) + ((size_t)j * NBS + b) * COLSA : nullptr);
#pragma unroll
        for (int i = 0; i < 6; ++i) { const int c = lane + 64 * i; float v = 0.f;
            if (c < 288) { const int cc = 3072 + c; const float z = zr[cc], p = zp ? zp[cc] : 0.f, zs = z + (p - z) * mu[cc]; v = c < 64 ? tanhf(zs) : (c < 128 ? zs : sigmoid_acc(zs)); }
            A2[(size_t)m * 384 + c] = (bf16)f2bf(v); }
#pragma unroll
        for (int i = 0; i < 4; ++i) { const int ch = lane * 4 + 256 * i; f32x4 acc = *(const f32x4*)(cb + ch);
#pragma unroll
            for (int jj = 0; jj < 4; ++jj) { const int s = t - 3 + jj; f32x4 xin = (f32x4){0.f, 0.f, 0.f, 0.f};
                if (s >= 0) xin = *(const f32x4*)(zr + (ptrdiff_t)(s - t) * ZP + COLSA + ch);
                else if (smp) xin = *(const f32x4*)(INP(5) + (((size_t)j * NBS + b) * 3 + (3 + s)) * 1024 + ch);
                acc += xin * *(const f32x4*)(cw + jj * 1024 + ch); }
            *(v2u*)(XCB + (size_t)m * 1024 + ch) = (v2u){pk2(acc[0], acc[1]), pk2(acc[2], acc[3])}; }
        if (t == T - 1) { float* dst = OUTP + (smp ? O_S_SHIFT + ((size_t)j * NBS + b) * COLSA : O_P_SHIFT + ((size_t)j * NBP + b) * COLSA);
            for (int c = lane * 4; c < COLSA; c += 256) *(f32x4*)(dst + c) = *(const f32x4*)(zr + c); }
        if (t >= T - 3) { const int r = t - (T - 3); float* dst = OUTP + (smp ? O_S_CONV + (((size_t)j * NBS + b) * 3 + r) * 1024 : O_P_CONV + (((size_t)j * NBP + b) * 3 + r) * 1024);
#pragma unroll
            for (int i = 0; i < 4; ++i) { const int ch = lane * 4 + 256 * i; *(f32x4*)(dst + ch) = *(const f32x4*)(zr + COLSA + ch); } }
    }
}
DI void mix_pass_b(KA a, Frame& F, int j) {
    unsigned char* ar = WSP + WS_AR; const float* Z = (const float*)(ar + AR_Z); const bf16* XCB = (const bf16*)(ar + AR_XCB); float* L = (float*)(ar + AR_L); float* GT = (float*)(ar + AR_GT);
    float* RW = (float*)(ar + AR_RW); float* BON = (float*)(ar + AR_BON);
    const float* mu = INP(23) + j * COLSA; const float* w0 = INP(24) + j * 1024; const float* a0 = INP(26) + j * 1024; const float* kka = INP(29) + j * 1024; const float* kaa = INP(30) + j * 1024; const float* rk = INP(31) + j * 1024;
    const float* ba = INP(37) + j * 1024; const float* bx = INP(39) + j * 1024; const float* lam = INP(40) + j * 1024; const int lane = F.lane;
    for (int m = F.gw; m < M; m += F.NGW) {
        const bool smp = m >= MPR; const int b = smp ? (m - MPR) >> 3 : m >> 11, t = smp ? (m - MPR) & 7 : m & 2047;
        const float* zr = Z + (size_t)m * ZP; const float* zp = t > 0 ? zr - ZP : (smp ? INP(3) + ((size_t)j * NBS + b) * COLSA : nullptr);
        float* Lr = L + (size_t)m * 3072;
        for (int h = 0; h < 16; ++h) { const int c = h * 64 + lane;
            const float zr_ = zr[c], zk_ = zr[1024 + c], zv_ = zr[2048 + c];
            const float pr = zp ? zp[c] : 0.f, pk = zp ? zp[1024 + c] : 0.f, pv = zp ? zp[2048 + c] : 0.f;
            const float r = zr_ + (pr - zr_) * mu[c], k = zk_ + (pk - zk_) * mu[1024 + c], v = zv_ + (pv - zv_) * mu[2048 + c];
            const float wl = -softplus_acc(-(w0[c] + Lr[c])) - 0.5f, w = expf(-expf(wl));
            const float aa = sigmoid_acc(a0[c] + Lr[1024 + c]);
            float kk = k * kka[c]; const float n2 = wave_sum(kk * kk); kk = kk / fmaxf(sqrtf(n2), 1e-12f);
            const float kp = k * (1.0f + (aa - 1.0f) * kaa[c]);
            const float bon = wave_sum(r * kp * rk[c]);
            float* p = RW + rw_off(smp, b, h, t);
            p[lane] = r; p[64 + lane] = w; p[128 + lane] = kp; p[192 + lane] = kk; p[256 + lane] = kk * aa; p[320 + lane] = v;
            if (lane == 0) BON[(size_t)m * 16 + h] = bon; }
#pragma unroll
        for (int i = 0; i < 4; ++i) { const int ch = lane * 4 + 256 * i; float* gp = GT + (size_t)m * 2048 + ch;
            const f32x4 gr = *(const f32x4*)gp, gi = *(const f32x4*)(gp + 1024), zg = *(const f32x4*)(zr + 4384 + ch); const v2u xw = *(const v2u*)(XCB + (size_t)m * 1024 + ch);
            const float xc[4] = {bf_lo(xw[0]), bf_hi(xw[0]), bf_lo(xw[1]), bf_hi(xw[1])}; f32x4 av, bv, gb;
#pragma unroll
            for (int e = 0; e < 4; ++e) { const float g_r = sigmoid_acc(gr[e] + ba[ch + e]), g_i = sigmoid_acc(gi[e] + bx[ch + e]); const float la = -8.0f * g_r * softplus_acc(-lam[ch + e]);
                av[e] = expf(la); bv[e] = sqrtf(-expm1f(2.0f * la)) * (g_i * xc[e]); gb[e] = gelu_tanh(zg[e]); }
            *(f32x4*)gp = av; *(f32x4*)(gp + 1024) = bv; *(f32x4*)(Lr + ch) = gb; }
    }
}
DI void mix_pass_c(KA a, Frame& F, int j) {
    unsigned char* ar = WSP + WS_AR; const float* Y = (const float*)(ar + AR_Y); bf16* YMIX = (bf16*)(ar + AR_YMIX); const float* L = (const float*)(ar + AR_L); const float* RW = (const float*)(ar + AR_RW); const float* BON = (const float*)(ar + AR_BON);
    const float* lg = INP(32) + j * 1024; const float* lb = INP(33) + j * 1024; const int lane = F.lane;
    for (int m = F.gw; m < M; m += F.NGW) {
        const bool smp = m >= MPR; const int b = smp ? (m - MPR) >> 3 : m >> 11, t = smp ? (m - MPR) & 7 : m & 2047;
        for (int h = 0; h < 16; ++h) { const int c = h * 64 + lane; const float y = Y[(size_t)m * 1024 + c];
            const float mean = wave_sum(y) * (1.0f / 64.0f), d = y - mean, var = wave_sum(d * d) * (1.0f / 64.0f);
            const float yn = d * (1.0f / sqrtf(var + GN_EPS)) * lg[c] + lb[c];
            const float v = RW[rw_off(smp, b, h, t) + 320 + lane], g = L[(size_t)m * 3072 + 2048 + c];
            YMIX[(size_t)m * 2048 + c] = (bf16)f2bf((yn + BON[(size_t)m * 16 + h] * v) * g); }
    }
}
DI void rwkv_job(Frame& F, const float* rw, int T, const float* s_in, float* s_out, float* Yp, int half) {
    LAS float* lds = (LAS float*)F.lds; LAS float* ybuf = lds + 2 * 6144;
    const int tid = F.tid, lane = F.lane, q = lane & 15, rl = F.wave * 4 + (lane >> 4), i = half * 32 + rl;
    f32x4 S = s_in ? *(const f32x4*)(s_in + i * 64 + 4 * q) : (f32x4){0.f, 0.f, 0.f, 0.f};
    const int nch = (T + 15) >> 4; f32x4 pre[3];
    { const int ns = T < 16 ? T : 16;
#pragma unroll
      for (int k = 0; k < 3; ++k) { const int idx = (tid + 512 * k) * 4; if (idx < ns * 384) *(LAS f32x4*)(lds + idx) = *(const f32x4*)(rw + idx); } }
    __syncthreads();
    for (int c = 0; c < nch; ++c) {
        const int cur = c & 1, ns = (T - 16 * c) < 16 ? (T - 16 * c) : 16; const bool more = (c + 1 < nch); const int nsn = more ? ((T - 16 * (c + 1)) < 16 ? (T - 16 * (c + 1)) : 16) : 0;
        if (more) { const float* src = rw + (size_t)(c + 1) * 6144;
#pragma unroll
            for (int k = 0; k < 3; ++k) { const int idx = (tid + 512 * k) * 4; pre[k] = (idx < nsn * 384) ? *(const f32x4*)(src + idx) : (f32x4){0.f, 0.f, 0.f, 0.f}; } }
        LAS float* buf = lds + cur * 6144;
        for (int tt = 0; tt < ns; ++tt) { LAS float* bs = buf + tt * 384;
            const f32x4 r4 = *(LAS f32x4*)(bs + 4 * q), w4 = *(LAS f32x4*)(bs + 64 + 4 * q), k4 = *(LAS f32x4*)(bs + 128 + 4 * q), kk4 = *(LAS f32x4*)(bs + 192 + 4 * q), b4 = *(LAS f32x4*)(bs + 256 + 4 * q); const float v = bs[320 + i];
            float sa = -((S[0] * kk4[0] + S[1] * kk4[1]) + (S[2] * kk4[2] + S[3] * kk4[3])); sa = sum16(sa);
            S = S * w4 + sa * b4 + v * k4;
            float y = (S[0] * r4[0] + S[1] * r4[1]) + (S[2] * r4[2] + S[3] * r4[3]); y = sum16(y);
            if (q == 0) ybuf[tt * 32 + rl] = y; }
        __syncthreads();
        { const int tt = tid >> 5, rr = tid & 31; if (tt < ns) Yp[(size_t)(16 * c + tt) * 1024 + half * 32 + rr] = ybuf[tid]; }
        if (more) { LAS float* nb = lds + (cur ^ 1) * 6144;
#pragma unroll
            for (int k = 0; k < 3; ++k) { const int idx = (tid + 512 * k) * 4; if (idx < nsn * 384) *(LAS f32x4*)(nb + idx) = pre[k]; } }
        __syncthreads();
    }
    *(f32x4*)(s_out + i * 64 + 4 * q) = S;
}
DI void scan_phase(KA a, Frame& F, int j) {
    unsigned char* ar = WSP + WS_AR; const float* RW = (const float*)(ar + AR_RW); float* Y = (float*)(ar + AR_Y); bf16* YMIX = (bf16*)(ar + AR_YMIX); const float* GT = (const float*)(ar + AR_GT); const float* L = (const float*)(ar + AR_L);
    const int nA = F.G / 2;
    if (F.vcu < nA) {
        for (int pj = F.vcu; pj < 128; pj += nA) { const int half = pj & 1, bh = pj >> 1, b = bh >> 4, h = bh & 15;
            rwkv_job(F, RW + (size_t)bh * 2048 * 384, TP, nullptr, OUTP + O_P_WKV + (((size_t)j * NBP + b) * 16 + h) * 4096, Y + (size_t)(b * TP) * 1024 + h * 64, half); }
    } else {
        const int w2 = F.vcu - nA, n2 = F.G - nA; LAS float* sA = (LAS float*)F.lds; LAS float* sB = sA + 512;
        for (int lj = w2; lj < 128; lj += n2) { const int b = lj >> 5, ch = (lj & 31) * 32 + (F.tid & 31), seg = F.tid >> 5; const size_t m0 = (size_t)b * TP + seg * 128;
            float A = 1.f, Bv = 0.f;
#pragma unroll 8
            for (int t = 0; t < 128; ++t) { const float a_ = GT[(m0 + t) * 2048 + ch], b_ = GT[(m0 + t) * 2048 + 1024 + ch]; Bv = a_ * Bv + b_; A *= a_; }
            sA[F.tid] = A; sB[F.tid] = Bv; __syncthreads();
            float hh = 0.f; for (int s = 0; s < seg; ++s) hh = sA[s * 32 + (F.tid & 31)] * hh + sB[s * 32 + (F.tid & 31)];
#pragma unroll 8
            for (int t = 0; t < 128; ++t) { const float a_ = GT[(m0 + t) * 2048 + ch], b_ = GT[(m0 + t) * 2048 + 1024 + ch]; hh = a_ * hh + b_; YMIX[(m0 + t) * 2048 + 1024 + ch] = (bf16)f2bf(hh * L[(m0 + t) * 3072 + ch]); }
            if (seg == 15) OUTP[O_P_H + ((size_t)j * NBP + b) * 1024 + ch] = hh;
            __syncthreads(); }
        for (int sj = w2; sj < 256; sj += n2) { const int idx = sj * 512 + F.tid, b = idx >> 10, ch = idx & 1023; float hh = INP(4)[((size_t)j * NBS + b) * 1024 + ch];
#pragma unroll
            for (int t = 0; t < 8; ++t) { const size_t m = MPR + b * 8 + t; hh = GT[m * 2048 + ch] * hh + GT[m * 2048 + 1024 + ch]; YMIX[m * 2048 + 1024 + ch] = (bf16)f2bf(hh * L[m * 3072 + ch]); }
            OUTP[O_S_H + ((size_t)j * NBS + b) * 1024 + ch] = hh; }
        for (int sj = w2; sj < 4096; sj += n2) { const int half = sj & 1, bh = sj >> 1, b = bh >> 4, h = bh & 15; const size_t so = (((size_t)j * NBS + b) * 16 + h) * 4096;
            rwkv_job(F, RW + RW_PROMPT + (size_t)bh * 8 * 384, TS, INP(2) + so, OUTP + O_S_WKV + so, Y + (size_t)(MPR + b * 8) * 1024 + h * 64, half); }
    }
}
template <bool SMP> DI void s5_job(KA a, Frame& F, int j, int g, size_t m0, int nchunks, int b0, const bf16* XB, const float* ssq) {
    unsigned char* ws = WSP; const int lane = F.lane, t16 = lane & 15, quad = lane >> 4;
    LAS float* BUc = (LAS float*)(F.lds + F.wave * 12800); LAS unsigned* Hc = (LAS unsigned*)(F.lds + F.wave * 12800 + 8448);
    bf16* ZG = (bf16*)(ws + WS_AR + AR_ZG);
    bf16x8 bub[8], cb[4];
#pragma unroll
    for (int nb = 0; nb < 8; ++nb) bub[nb] = *(const bf16x8*)(ws + WS_S5BUB + ((((size_t)j * 128 + g) * 8 + nb) * 64 + lane) * 16);
#pragma unroll
    for (int ks = 0; ks < 4; ++ks) cb[ks] = *(const bf16x8*)(ws + WS_S5CB + ((((size_t)j * 128 + g) * 4 + ks) * 64 + lane) * 16);
    const f32x2 ab = *(const f32x2*)(ws + WS_S5AB + (((size_t)j * 128 + g) * 64 + lane) * 8); const float ar_ = ab[0], ai_ = ab[1];
    const float dg = ((const float*)(ws + WS_S5DG))[j * 2048 + g * 16 + t16];
    float hr = 0.f, hi = 0.f;
    for (int c = 0; c < nchunks; ++c) { const size_t mc = m0 + (size_t)c * 16;
        bf16x8 af = (bf16x8){0, 0, 0, 0, 0, 0, 0, 0}; if (quad < 2) af = *(const bf16x8*)(XB + (mc + t16) * 2048 + g * 16 + quad * 8);
        float rs[4];
#pragma unroll
        for (int jj = 0; jj < 4; ++jj) rs[jj] = __builtin_amdgcn_rsqf(ssq[mc + quad * 4 + jj] * (1.0f / 2048.0f) + 1e-6f);
#pragma unroll
        for (int nb = 0; nb < 8; ++nb) { const f32x4 d = __builtin_amdgcn_mfma_f32_16x16x32_bf16(af, bub[nb], (f32x4){0.f, 0.f, 0.f, 0.f}, 0, 0, 0);
#pragma unroll
            for (int jj = 0; jj < 4; ++jj) BUc[(quad * 4 + jj) * 132 + nb * 16 + t16] = d[jj] * rs[jj]; }
        LDS_WAIT(); asm volatile("" ::: "memory");
#pragma unroll
        for (int tt = 0; tt < 16; ++tt) {
            if (SMP && (tt & 7) == 0) { const size_t si = (((size_t)j * NBS + (b0 + 2 * c + (tt >> 3))) * 128 + g) * 64 + lane; hr = INP(6)[si]; hi = INP(7)[si]; }
            const f32x2 bu = *(LAS f32x2*)(BUc + tt * 132 + 2 * lane);
            const float nr = ar_ * hr - ai_ * hi + bu[0], ni = ar_ * hi + ai_ * hr + bu[1]; hr = nr; hi = ni;
            Hc[tt * 68 + lane] = pg8::cvt_pk_bf16(hr, hi);
            if (SMP && (tt & 7) == 7) { const size_t si = (((size_t)j * NBS + (b0 + 2 * c + (tt >> 3))) * 128 + g) * 64 + lane; OUTP[O_S_CRE + si] = hr; OUTP[O_S_CIM + si] = hi; }
        }
        LDS_WAIT(); asm volatile("" ::: "memory");
        f32x4 acc = (f32x4){0.f, 0.f, 0.f, 0.f};
#pragma unroll
        for (int ks = 0; ks < 4; ++ks) { const bf16x8 ah = *(LAS bf16x8*)((LAS unsigned char*)Hc + t16 * 272 + ks * 64 + quad * 16); acc = __builtin_amdgcn_mfma_f32_16x16x32_bf16(ah, cb[ks], acc, 0, 0, 0); }
#pragma unroll
        for (int jj = 0; jj < 4; ++jj) { const size_t o = (mc + quad * 4 + jj) * 2048 + g * 16 + t16; const float xb = __uint_as_float((unsigned)XB[o] << 16);
            ZG[o] = (bf16)f2bf(gelu_tanh(acc[jj] + dg * rs[jj] * xb)); }
        LDS_WAIT(); asm volatile("" ::: "memory");
    }
    if (!SMP) { const int b = (int)(m0 >> 11); const size_t si = (((size_t)j * NBP + b) * 128 + g) * 64 + lane; OUTP[O_P_CRE + si] = hr; OUTP[O_P_CIM + si] = hi; }
}
DI void s5_phase(KA a, Frame& F, int j, const bf16* XB, const float* ssq) {
    if (F.wave < 2) { for (int jp = F.vcu * 2 + F.wave; jp < 512; jp += F.G * 2) { const int b = jp >> 7, g = jp & 127; s5_job<false>(a, F, j, g, (size_t)b * TP, 128, 0, XB, ssq); } }
    else { for (int js = F.vcu * 6 + (F.wave - 2); js < 1024; js += F.G * 6) { const int g = js >> 3, s = js & 7; s5_job<true>(a, F, j, g, (size_t)MPR + (size_t)s * 128, 8, 16 * s, XB, ssq); } }
}
DI void final_phase(KA a, Frame& F, const float* ssq) {
    const float* X = (const float*)(WSP + WS_X); const float* fn = INP(52);
    for (int m = F.gw; m < M; m += F.NGW) { const float rs = 1.0f / sqrtf(ssq[m] * (1.0f / 2048.0f) + 1e-6f);
#pragma unroll
        for (int i = 0; i < 8; ++i) { const int c = F.lane * 4 + 256 * i; *(f32x4*)(OUTP + (size_t)m * D + c) = *(const f32x4*)(X + (size_t)m * D + c) * rs * *(const f32x4*)(fn + c); } }
}
#define GEMM_SITE(EPI, AEXPR, BEXPR, NN, KK, ...) do { FRESH(a); unsigned char* ws = WSP; unsigned char* ar = ws + WS_AR; float* X = (float*)(ws + WS_X); float* SSQ = (float*)(ws + WS_SSQ); (void)ar; (void)X; (void)SSQ; \
        bf16* XBc = (bf16*)(ws + WS_XB + (size_t)xcur * ((size_t)M * D * 2)); bf16* XBn = (bf16*)(ws + WS_XB + (size_t)(xcur ^ 1) * ((size_t)M * D * 2)); (void)XBc; (void)XBn; \
        pg8::Gemm g_{(const bf16*)(AEXPR), (const bf16*)(BEXPR), M, NN, KK}; pg8::StaticOrder S_; S_.init(M, NN, F.G, (int)blockIdx.x); \
        EPI E_{__VA_ARGS__}; pg8::gemm_phase<EPI, pg8::StaticOrder, true, true>(F.lds + RING_OFF, g_, S_, E_); } while (0)
__global__ void __launch_bounds__(NWAVES * 64, 2) trunk_fwd(Args args_by_value) {
    extern __shared__ __attribute__((aligned(16))) unsigned char lds[];
    KA a = (KA)__builtin_amdgcn_kernarg_segment_ptr();
    Frame F;
    F.lds = (LAS unsigned char*)lds; F.MISC = (volatile LAS unsigned*)(F.lds + MISC_OFF);
    F.tid = threadIdx.x; F.lane = F.tid & 63; F.wave = __builtin_amdgcn_readfirstlane(F.tid >> 6);
    F.G = gridDim.x; { const int bx = blockIdx.x; F.vcu = (F.G % 8 == 0) ? (bx % 8) * (F.G / 8) + bx / 8 : bx; }
    F.gw = F.vcu * NWAVES + F.wave; F.NGW = F.G * NWAVES;
    for (int u = F.tid; u < (LDS_BYTES - LDSCTL_OFF) / 4; u += NWAVES * 64) ((LAS unsigned*)(F.lds + LDSCTL_OFF))[u] = 0u;
    __syncthreads();
    (void)xcd_barrier_post((unsigned*)(WSP + WS_CTL) + CW_BAR, F.MISC + 8);
#define GRID_BAR() do { FRESH(a); XcdBarrier b_; b_.bar = (unsigned*)(WSP + WS_CTL) + CW_BAR; b_.x = xb_xcc_id(); b_.st = F.MISC + 8; xcd_barrier(b_); } while (0)

    FRESH(a); refresh(F); p0_prologue(a, F); GRID_BAR();

    int xcur = 0;
    for (int hl = 0; hl < 8; ++hl) {
        const int l = hl >> 1, f = hl & 1, lf = hl;
        GEMM_SITE(pg8::EpiSwiGLU, XBc, ws + WS_WGU + (size_t)lf * SZ_WGU, NGU, D, (bf16*)(ar + AR_HID), FF, SSQ + (size_t)(4 * l + 2 * f) * M);
        GRID_BAR();
        GEMM_SITE(pg8::EpiRes<0>, ar + AR_HID, ws + WS_WD + (size_t)lf * SZ_WD, D, FF, X, XBc, SSQ + (size_t)(4 * l + 2 * f + 1) * M, 0.5f, nullptr, nullptr, nullptr, nullptr);
        GRID_BAR();
        if (f == 0) {
            const int j = l >> 1;
            if ((l & 1) == 0) {
                GEMM_SITE(pg8::EpiF32, XBc, ws + WS_WIN + (size_t)j * SZ_WIN, ZP, D, (float*)(ar + AR_Z), ZP, SSQ + (size_t)(4 * l + 1) * M);
                GRID_BAR();
                FRESH(a); refresh(F); mix_pass_a(a, F, j);
                GRID_BAR();
                GEMM_SITE(pg8::EpiF32, ar + AR_A2, ws + WS_WLORA + (size_t)j * SZ_WLORA, 3072, 384, (float*)(ar + AR_L), 3072, nullptr);
                GEMM_SITE(pg8::EpiF32, ar + AR_XCB, ws + WS_WGATE + (size_t)j * SZ_WGATE, 2048, 1024, (float*)(ar + AR_GT), 2048, nullptr);
                GRID_BAR();
                FRESH(a); refresh(F); mix_pass_b(a, F, j);
                GRID_BAR();
                FRESH(a); refresh(F); scan_phase(a, F, j);
                GRID_BAR();
                FRESH(a); refresh(F); mix_pass_c(a, F, j);
                GRID_BAR();
                GEMM_SITE(pg8::EpiRes<0>, ar + AR_YMIX, ws + WS_WOUT + (size_t)j * SZ_SQ, D, D, X, XBc, SSQ + (size_t)(4 * l + 2) * M, 1.0f, nullptr, nullptr, nullptr, nullptr);
                GRID_BAR();
            } else {
                FRESH(a); refresh(F); s5_phase(a, F, j, (const bf16*)(WSP + WS_XB + (size_t)xcur * ((size_t)M * D * 2)), (const float*)(WSP + WS_SSQ) + (size_t)(4 * l + 1) * M);
                GRID_BAR();
                GEMM_SITE(pg8::EpiRes<2>, ar + AR_ZG, ws + WS_WGLU + (size_t)j * SZ_SQ, D, D, X, XBc, SSQ + (size_t)(4 * l + 2) * M, 1.0f, nullptr, nullptr, (const bf16*)(ar + AR_ZG), INP(51) + j * 2048);
                GRID_BAR();
            }
        } else {
            GEMM_SITE(pg8::EpiF32, ws + WS_PB + (size_t)l * M * 256 * 2, ws + WS_PLEP + (size_t)l * SZ_PLEP, D, 256, (float*)(ar + AR_PPT), D, nullptr);
            GEMM_SITE(pg8::EpiRes<1>, XBc, ws + WS_PLEG + (size_t)l * SZ_SQ, D, D, X, XBn, SSQ + (size_t)(4 * l + 4) * M, 1.0f, SSQ + (size_t)(4 * l + 3) * M, (const float*)(ar + AR_PPT), nullptr, nullptr);
            GRID_BAR();
            xcur ^= 1;
        }
    }
    FRESH(a); refresh(F); final_phase(a, F, (const float*)(WSP + WS_SSQ) + (size_t)16 * M);
}

extern "C" void kernel_launch(void* const* d_in, const int* in_sizes, int n_in, void* d_out, int out_size, void* d_ws, size_t ws_size, hipStream_t stream) {
    static int grid = 0;
    if (grid == 0) {
        if (n_in != 53 || out_size != (int)O_END || ws_size < WS_END) { fprintf(stderr, "kernel_launch: unexpected problem (n_in %d, out %d, ws %zu, need %zu)\n", n_in, out_size, ws_size, (size_t)WS_END); grid = -1; return; }
        int dev = 0, cus = 0, per_cu = 0;
        if (hipGetDevice(&dev) != hipSuccess || hipDeviceGetAttribute(&cus, hipDeviceAttributeMultiprocessorCount, dev) != hipSuccess) { grid = -1; return; }
        if (hipFuncSetAttribute((const void*)trunk_fwd, hipFuncAttributeMaxDynamicSharedMemorySize, LDS_BYTES) != hipSuccess) { fprintf(stderr, "kernel_launch: hipFuncSetAttribute failed\n"); grid = -1; return; }
        if (hipOccupancyMaxActiveBlocksPerMultiprocessor(&per_cu, (const void*)trunk_fwd, NWAVES * 64, LDS_BYTES) != hipSuccess || per_cu < 1) { fprintf(stderr, "kernel_launch: occupancy query says %d blocks per CU\n", per_cu); (void)hipGetLastError(); grid = -1; return; }
        grid = cus;
    }
    if (grid < 0) return;
    if (hipMemsetAsync((char*)d_ws + WS_CTL, 0, CTL_ZERO_BYTES, stream) != hipSuccess) return;
    Args a{};
    for (int i = 0; i < 53; ++i) a.in[i] = (const float*)d_in[i];
    a.out = (float*)d_out; a.ws = (unsigned char*)d_ws;
    hipLaunchKernelGGL(trunk_fwd, dim3(grid), dim3(NWAVES * 64), LDS_BYTES, stream, a);
}
```

```cpp
#include <hip/hip_runtime.h>
#include <cstdio>
#include <cstdint>
namespace pg8 {
#define PG8_LAS __attribute__((address_space(3)))
typedef unsigned short bf16_t;
typedef short bf16x8 __attribute__((ext_vector_type(8)));
typedef float f32x4 __attribute__((ext_vector_type(4)));
typedef unsigned u32x4 __attribute__((ext_vector_type(4)));
constexpr int BM = 256, BK = 64, HALF = 128, HTB = HALF * BK * 2  , STAGE_BYTES = 8 * HTB, NXCD = 8, WGM = 8;

__host__ __device__ __forceinline__ int lds_byte(int r, int c) { const int st = (r >> 4) * 2 + (c >> 5), rr = r & 15, cc = c & 31, ob = rr * 64 + cc * 2; return st * 1024 + (ob ^ (((ob >> 9) & 1) << 5)); }
__host__ __device__ __forceinline__ void stage_rc(int b, int& R, int& C) { const int st = b / 1024, sb = b % 1024, swz = sb ^ (((sb >> 9) & 1) << 5); R = (st >> 1) * 16 + swz / 64; C = (st & 1) * 32 + (swz % 64) / 2; }
__host__ __device__ __forceinline__ int perm32(int rho) { const int n = rho >> 4, i = rho & 15; return 8 * (i >> 2) + 4 * n + (i & 3); }

struct Unit { int pm, pn; };
struct Gemm { const bf16_t* A; const bf16_t* Bt; int M, N, K; };

struct StaticOrder {
    int nM, nN, nwg, G, c;
    __host__ __device__ void init(int M, int N, int G_, int c_) { nM = M / BM; nN = N / BM; nwg = nM * nN; G = G_; c = c_; }
    __host__ __device__ bool next(int i, Unit& u) const {
        const long L = (long)i * G + c; if (L >= nwg) return false;
        int wgid = (int)L; { const int q = nwg / NXCD, r = nwg % NXCD, xcd = wgid % NXCD, off = wgid / NXCD; wgid = (xcd < r ? xcd * (q + 1) : r * (q + 1) + (xcd - r) * q) + off; }
        const int nig = WGM * nN, gid = wgid / nig, fm = gid * WGM, gsz = (nM - fm) < WGM ? (nM - fm) : WGM;
        u.pm = fm + ((wgid % nig) % gsz); u.pn = (wgid % nig) / gsz; return true;
    }
    __device__ __forceinline__ void a_ready(const Unit&) const {}
    __device__ __forceinline__ void done(const Unit&) const {}
};

__device__ __forceinline__ unsigned cvt_pk_bf16(float lo, float hi) { unsigned r; asm volatile("v_cvt_pk_bf16_f32 %0, %1, %2" : "=v"(r) : "v"(lo), "v"(hi)); return r; }
typedef float f32x2 __attribute__((ext_vector_type(2)));
constexpr float RMS_EPS_F = 1e-6f, INV_D = 1.0f / 2048.0f;
__device__ __forceinline__ float rstd_of(const float* ssq, int row) { return __builtin_amdgcn_rsqf(ssq[row] * INV_D + RMS_EPS_F); }
__device__ __forceinline__ float sigm(float x) { return __builtin_amdgcn_rcpf(1.0f + __builtin_amdgcn_exp2f(-1.44269504f * x)); }
typedef unsigned u32x2 __attribute__((ext_vector_type(2)));
struct EpiF32 {
    static constexpr bool PERM = false, AFTER_DRAIN = false;
    float* C; int ldc; const float* ssq;
    __device__ __forceinline__ void operator()(const f32x4 (&acc)[2][2][4][2], const Unit& u, int wr, int wc, int fr, int fq) const {
        const int row0 = u.pm * BM + wr * 64 + fr, col0 = u.pn * BM + wc * 32 + 4 * fq;
#pragma unroll
        for (int ai = 0; ai < 2; ++ai)
#pragma unroll
            for (int m = 0; m < 4; ++m) { const int row = row0 + ai * HALF + m * 16; const float rs = ssq ? rstd_of(ssq, row) : 1.0f; float* rowp = C + (size_t)row * ldc + col0;
#pragma unroll
                for (int bj = 0; bj < 2; ++bj)
#pragma unroll
                    for (int n = 0; n < 2; ++n) *(f32x4*)(rowp + bj * HALF + n * 16) = acc[ai][bj][m][n] * rs; }
    }
};
struct EpiSwiGLU {
    static constexpr bool PERM = true, AFTER_DRAIN = false;
    bf16_t* H; int ldh; const float* ssq;
    __device__ __forceinline__ void operator()(const f32x4 (&acc)[2][2][4][2], const Unit& u, int wr, int wc, int fr, int fq) const {
        const int row0 = u.pm * BM + wr * 64 + fr, col0 = u.pn * HALF + wc * 32 + 8 * fq;
#pragma unroll
        for (int ai = 0; ai < 2; ++ai)
#pragma unroll
            for (int m = 0; m < 4; ++m) { const int row = row0 + ai * HALF + m * 16; const float rs = rstd_of(ssq, row); u32x4 w;
#pragma unroll
                for (int n = 0; n < 2; ++n) { const f32x4 g = acc[ai][0][m][n] * rs, uu = acc[ai][1][m][n] * rs; f32x4 h;
#pragma unroll
                    for (int e = 0; e < 4; ++e) h[e] = g[e] * uu[e] * sigm(g[e]);
                    w[2 * n] = cvt_pk_bf16(h[0], h[1]); w[2 * n + 1] = cvt_pk_bf16(h[2], h[3]); }
                *(u32x4*)(H + (size_t)row * ldh + col0) = w; }
    }
};
template <int MODE> struct EpiRes {
    static constexpr bool PERM = false, AFTER_DRAIN = false;
    float* X; bf16_t* XB; float* ssq_out; float scale; const float* ssq_in; const float* PP; const bf16_t* ZG; const float* bias;
    __device__ __forceinline__ void operator()(const f32x4 (&acc)[2][2][4][2], const Unit& u, int wr, int wc, int fr, int fq) const {
        const int row0 = u.pm * BM + wr * 64 + fr, col0 = u.pn * BM + wc * 32 + 4 * fq;
#pragma unroll
        for (int ai = 0; ai < 2; ++ai)
#pragma unroll
            for (int m = 0; m < 4; ++m) { const int row = row0 + ai * HALF + m * 16; const size_t off = (size_t)row * 2048 + col0; float s = 0.f;
                const float rs = (MODE == 1) ? rstd_of(ssq_in, row) : 1.0f;
#pragma unroll
                for (int bj = 0; bj < 2; ++bj)
#pragma unroll
                    for (int n = 0; n < 2; ++n) { const size_t o = off + bj * HALF + n * 16; const f32x4 xv = *(const f32x4*)(X + o); f32x4 d;
                        if (MODE == 0) d = acc[ai][bj][m][n] * scale;
                        if (MODE == 1) { const f32x4 pp = *(const f32x4*)(PP + o); const f32x4 a = acc[ai][bj][m][n] * rs;
#pragma unroll
                            for (int e = 0; e < 4; ++e) d[e] = sigm(a[e]) * pp[e]; }
                        if (MODE == 2) { const u32x2 zz = *(const u32x2*)(ZG + o); const f32x4 bv = *(const f32x4*)(bias + col0 + bj * HALF + n * 16); const f32x4 a = acc[ai][bj][m][n] + bv;
                            f32x4 z; z[0] = __uint_as_float(zz[0] << 16); z[1] = __uint_as_float(zz[0] & 0xffff0000u); z[2] = __uint_as_float(zz[1] << 16); z[3] = __uint_as_float(zz[1] & 0xffff0000u);
#pragma unroll
                            for (int e = 0; e < 4; ++e) d[e] = z[e] * sigm(a[e]); }
                        const f32x4 xn = xv + d; *(f32x4*)(X + o) = xn; u32x2 w; w[0] = cvt_pk_bf16(xn[0], xn[1]); w[1] = cvt_pk_bf16(xn[2], xn[3]); *(u32x2*)(XB + o) = w;
                        s += (xn[0] * xn[0] + xn[1] * xn[1]) + (xn[2] * xn[2] + xn[3] * xn[3]); }
                s += __shfl_xor(s, 16); s += __shfl_xor(s, 32);
                if (fq == 0) __hip_atomic_fetch_add(ssq_out + row, s, __ATOMIC_RELAXED, __HIP_MEMORY_SCOPE_AGENT); }
    }
};
template <class Epi, class Sched, bool ALIGN_EPI = false, bool SP2 = false>
__device__ __forceinline__ void gemm_phase(PG8_LAS unsigned char* lds, const Gemm g, const Sched& S, const Epi& E) {
    int tid_ = threadIdx.x; asm volatile("" : "+v"(tid_));
    const int tid = tid_, wid = __builtin_amdgcn_readfirstlane(tid >> 6), lane = tid & 63, wr = wid >> 2, wc = wid & 3, fr = lane & 15, fq = lane >> 4;
    const int K = g.K, nt = K / BK;
    unsigned voffA[2], voffB[2];
#pragma unroll
    for (int i = 0; i < 2; ++i) { int R, C; stage_rc(tid * 16 + i * 8192, R, C); const int Rb = Epi::PERM ? ((R & ~31) + perm32(R & 31)) : R;
        voffA[i] = (unsigned)(R * K + C) * 2u; voffB[i] = (unsigned)(Rb * K + C) * 2u; }
    const size_t kstep = (size_t)(BK * 2);
    const size_t hstep = (size_t)HALF * K * 2;
    const size_t tstep = 2 * hstep;
    const unsigned ldsw = (unsigned)wid * 1024u;
    const int aoff = lds_byte(wr * 64 + fr, fq * 8), boff = lds_byte(wc * 32 + fr, fq * 8);
#define PG8_SA(b, h) (((b) * 2 + (h)) * HTB)
#define PG8_SB(b, h) ((4 + (b) * 2 + (h)) * HTB)
#define PG8_STAGE(bufoff, gbase, voff) do { _Pragma("unroll") for (int _i = 0; _i < 2; ++_i) \
        __builtin_amdgcn_global_load_lds((const unsigned*)((const char*)(gbase) + (voff)[_i]), (PG8_LAS unsigned*)(lds + (bufoff) + ldsw + _i * 8192), 16, 0, 0); } while (0)
#define PG8_LDA(dst, b, h) do { _Pragma("unroll") for (int m = 0; m < 4; ++m) _Pragma("unroll") for (int k = 0; k < 2; ++k) dst[m][k] = *(const PG8_LAS bf16x8*)(lds + PG8_SA(b, h) + aoff + m * 2048 + k * 1024); } while (0)
#define PG8_LDB(dst, b, h) do { _Pragma("unroll") for (int n = 0; n < 2; ++n) _Pragma("unroll") for (int k = 0; k < 2; ++k) dst[n][k] = *(const PG8_LAS bf16x8*)(lds + PG8_SB(b, h) + boff + n * 2048 + k * 1024); } while (0)
#define PG8_MMA(ai, bj, At, Bt) do { __builtin_amdgcn_s_setprio(1); _Pragma("unroll") for (int m = 0; m < 4; ++m) _Pragma("unroll") for (int n = 0; n < 2; ++n) _Pragma("unroll") for (int k = 0; k < 2; ++k) \
        acc[ai][bj][m][n] = __builtin_amdgcn_mfma_f32_16x16x32_bf16(Bt[n][k], At[m][k], acc[ai][bj][m][n], 0, 0, 0); __builtin_amdgcn_s_setprio(0); } while (0)
#define PG8_WAIT_V(n) asm volatile("s_waitcnt vmcnt(" #n ")" ::: "memory")
#define PG8_WAIT_L(n) asm volatile("s_waitcnt lgkmcnt(" #n ")" ::: "memory")
#define PG8_BAR __builtin_amdgcn_s_barrier()
#define PG8_SCHED __builtin_amdgcn_sched_barrier(0)
    Unit cur, nxt; int ui = 0;
    if (!S.next(0, cur)) return;
    f32x4 acc[2][2][4][2];
#pragma unroll
    for (int a = 0; a < 2; ++a)
#pragma unroll
        for (int b = 0; b < 2; ++b)
#pragma unroll
            for (int m = 0; m < 4; ++m)
#pragma unroll
                for (int n = 0; n < 2; ++n) acc[a][b][m][n] = (f32x4){0.f, 0.f, 0.f, 0.f};
    bf16x8 At[4][2], B0[2][2], B1[2][2];
    const char* cA = (const char*)g.A + (size_t)cur.pm * tstep; const char* cB = (const char*)g.Bt + (size_t)cur.pn * tstep;
    S.a_ready(cur);
    if constexpr (SP2) {
        PG8_STAGE(PG8_SB(0, 0), cB, voffB); PG8_STAGE(PG8_SB(0, 1), cB + hstep, voffB); PG8_STAGE(PG8_SA(0, 0), cA, voffA); PG8_STAGE(PG8_SA(0, 1), cA + hstep, voffA);
        if (wr == 1) PG8_BAR;
        PG8_WAIT_V(2); PG8_BAR;
        PG8_STAGE(PG8_SB(1, 0), cB + kstep, voffB); PG8_STAGE(PG8_SA(1, 0), cA + kstep, voffA); PG8_STAGE(PG8_SB(1, 1), cB + hstep + kstep, voffB);
        PG8_WAIT_V(6); PG8_BAR;
    } else {
        PG8_STAGE(PG8_SB(0, 0), cB, voffB); PG8_STAGE(PG8_SA(0, 0), cA, voffA); PG8_STAGE(PG8_SB(0, 1), cB + hstep, voffB); PG8_STAGE(PG8_SA(0, 1), cA + hstep, voffA);
        if (wr == 1) PG8_BAR;
        PG8_WAIT_V(4); PG8_BAR;
        PG8_STAGE(PG8_SB(1, 0), cB + kstep, voffB); PG8_STAGE(PG8_SA(1, 0), cA + kstep, voffA); PG8_STAGE(PG8_SB(1, 1), cB + hstep + kstep, voffB);
        PG8_WAIT_V(6); PG8_BAR;
    }
    for (;;) {
        const bool has_next = S.next(ui + 1, nxt);
        const char* nA = has_next ? (const char*)g.A + (size_t)nxt.pm * tstep : cA; const char* nB = has_next ? (const char*)g.Bt + (size_t)nxt.pn * tstep : cB;
        for (int t = 0; t < nt; t += 2) {
            const bool last = (t == nt - 2);
            const char* a1 = cA + (size_t)(t + 1) * kstep;
            const char* a2 = last ? nA : cA + (size_t)(t + 2) * kstep; const char* b2 = last ? nB : cB + (size_t)(t + 2) * kstep;
            const char* a3 = a2 + kstep; const char* b3 = b2 + kstep;
            if (last && has_next) S.a_ready(nxt);
            if constexpr (SP2) {
            PG8_LDB(B0, 0, 0); PG8_LDB(B1, 0, 1); PG8_SCHED; PG8_LDA(At, 0, 0); PG8_STAGE(PG8_SA(1, 1), a1 + hstep, voffA);
            PG8_WAIT_V(8); PG8_WAIT_L(0); PG8_BAR; PG8_MMA(0, 0, At, B0); PG8_MMA(0, 1, At, B1); PG8_BAR; PG8_SCHED;
            PG8_LDA(At, 0, 1); PG8_STAGE(PG8_SB(0, 0), b2, voffB); PG8_STAGE(PG8_SB(0, 1), b2 + hstep, voffB); PG8_STAGE(PG8_SA(0, 0), a2, voffA);
            PG8_WAIT_V(8); PG8_WAIT_L(0); PG8_BAR; PG8_MMA(1, 0, At, B0); PG8_MMA(1, 1, At, B1); PG8_BAR; PG8_SCHED;
            PG8_LDB(B0, 1, 0); PG8_LDB(B1, 1, 1); PG8_SCHED; PG8_LDA(At, 1, 0); PG8_STAGE(PG8_SA(0, 1), a2 + hstep, voffA);
            PG8_WAIT_V(8); PG8_WAIT_L(0); PG8_BAR; PG8_MMA(0, 0, At, B0); PG8_MMA(0, 1, At, B1); PG8_BAR; PG8_SCHED;
            PG8_LDA(At, 1, 1); PG8_STAGE(PG8_SB(1, 0), b3, voffB); PG8_STAGE(PG8_SB(1, 1), b3 + hstep, voffB); PG8_STAGE(PG8_SA(1, 0), a3, voffA);
            PG8_WAIT_V(8); PG8_WAIT_L(0); PG8_BAR; PG8_MMA(1, 0, At, B0); PG8_MMA(1, 1, At, B1); PG8_BAR; PG8_SCHED;
            } else {
            PG8_LDB(B0, 0, 0); PG8_SCHED; PG8_LDA(At, 0, 0); PG8_STAGE(PG8_SA(1, 1), a1 + hstep, voffA);
            PG8_WAIT_L(8); PG8_BAR; PG8_WAIT_L(0); PG8_MMA(0, 0, At, B0); PG8_BAR; PG8_SCHED;
            PG8_LDB(B1, 0, 1); PG8_STAGE(PG8_SB(0, 0), b2, voffB);
            PG8_BAR; PG8_WAIT_L(0); PG8_MMA(0, 1, At, B1); PG8_BAR;
            PG8_LDA(At, 0, 1); PG8_STAGE(PG8_SA(0, 0), a2, voffA);
            PG8_BAR; PG8_WAIT_L(0); PG8_MMA(1, 0, At, B0); PG8_BAR; PG8_SCHED;
            PG8_STAGE(PG8_SB(0, 1), b2 + hstep, voffB);
            PG8_WAIT_V(6); PG8_BAR; PG8_MMA(1, 1, At, B1); PG8_BAR;
            PG8_LDB(B0, 1, 0); PG8_SCHED; PG8_LDA(At, 1, 0); PG8_STAGE(PG8_SA(0, 1), a2 + hstep, voffA);
            PG8_WAIT_L(8); PG8_BAR; PG8_WAIT_L(0); PG8_MMA(0, 0, At, B0); PG8_BAR; PG8_SCHED;
            PG8_LDB(B1, 1, 1); PG8_STAGE(PG8_SB(1, 0), b3, voffB);
            PG8_BAR; PG8_WAIT_L(0); PG8_MMA(0, 1, At, B1); PG8_BAR;
            PG8_LDA(At, 1, 1); PG8_STAGE(PG8_SA(1, 0), a3, voffA);
            PG8_BAR; PG8_WAIT_L(0); PG8_MMA(1, 0, At, B0); PG8_BAR; PG8_SCHED;
            PG8_STAGE(PG8_SB(1, 1), b3 + hstep, voffB);
            PG8_WAIT_V(6); PG8_BAR; PG8_MMA(1, 1, At, B1); PG8_BAR;
            }
        }
        if constexpr (ALIGN_EPI) { if (wr == 0) PG8_BAR; }
        if constexpr (!Epi::AFTER_DRAIN) { E(acc, cur, wr, wc, fr, fq); S.done(cur); }
        if (!has_next) break;
#pragma unroll
        for (int a = 0; a < 2; ++a)
#pragma unroll
            for (int b = 0; b < 2; ++b)
#pragma unroll
                for (int m = 0; m < 4; ++m)
#pragma unroll
                    for (int n = 0; n < 2; ++n) acc[a][b][m][n] = (f32x4){0.f, 0.f, 0.f, 0.f};
        cur = nxt; cA = nA; cB = nB; ++ui;
        if constexpr (ALIGN_EPI) { if (wr == 1) PG8_BAR; }
    }
    PG8_WAIT_V(0);
    if constexpr (!ALIGN_EPI) { if (wr == 0) PG8_BAR; }
    PG8_BAR;
    if constexpr (Epi::AFTER_DRAIN) { E.fused(acc, cur, wr, wc, fr, fq, lds, wid, lane); S.done(cur); }
#undef PG8_SA
#undef PG8_SB
#undef PG8_STAGE
#undef PG8_LDA
#undef PG8_LDB
#undef PG8_MMA
#undef PG8_WAIT_V
#undef PG8_WAIT_L
#undef PG8_BAR
#undef PG8_SCHED
}
}
constexpr int NWAVES = 8;
constexpr int M = 9216, MPR = 8192, D = 2048, FF = 5632, NGU = 11264, ZP = 5632, COLSA = 3360, TP = 2048, TS = 8, NBS = 128, NBP = 4;
constexpr int NSITE = 17;
constexpr float GN_EPS = 64e-5f;
constexpr size_t MiB = 1u << 20;
constexpr size_t WS_CTL = 0, CTL_ZERO_BYTES = 2 * MiB;
constexpr size_t WS_SSQ = 1 * MiB;
constexpr size_t WS_WGU = 2 * MiB, SZ_WGU = (size_t)NGU * D * 2;
constexpr size_t WS_WD = WS_WGU + 8 * SZ_WGU, SZ_WD = (size_t)D * FF * 2;
constexpr size_t WS_PLEG = WS_WD + 8 * SZ_WD, SZ_SQ = (size_t)D * D * 2;
constexpr size_t WS_PLEP = WS_PLEG + 4 * SZ_SQ, SZ_PLEP = (size_t)D * 256 * 2;
constexpr size_t WS_WIN = WS_PLEP + 4 * SZ_PLEP, SZ_WIN = (size_t)ZP * D * 2;
constexpr size_t WS_WOUT = WS_WIN + 2 * SZ_WIN;
constexpr size_t WS_WGLU = WS_WOUT + 2 * SZ_SQ;
constexpr size_t WS_WLORA = WS_WGLU + 2 * SZ_SQ, SZ_WLORA = (size_t)3072 * 384 * 2;
constexpr size_t WS_WGATE = WS_WLORA + 2 * SZ_WLORA, SZ_WGATE = (size_t)2048 * 1024 * 2;
constexpr size_t WS_S5AB = WS_WGATE + 2 * SZ_WGATE;
constexpr size_t WS_S5BUB = WS_S5AB + 256 * 1024, SZ_BUB = (size_t)128 * 8 * 64 * 16;
constexpr size_t WS_S5CB = WS_S5BUB + 2 * SZ_BUB, SZ_CB = (size_t)128 * 4 * 64 * 16;
constexpr size_t WS_S5DG = WS_S5CB + 2 * SZ_CB;
constexpr size_t WS_X = (WS_S5DG + 16384 + MiB - 1) / MiB * MiB;
constexpr size_t WS_XB = WS_X + (size_t)M * D * 4;
constexpr size_t WS_PB = WS_XB + (size_t)2 * M * D * 2;
constexpr size_t WS_AR = WS_PB + (size_t)4 * M * 256 * 2;
constexpr size_t AR_Z = 0;
constexpr size_t AR_A2 = AR_Z + (size_t)M * ZP * 4;
constexpr size_t AR_XCB = AR_A2 + (size_t)M * 384 * 2;
constexpr size_t AR_L = AR_XCB + (size_t)M * 1024 * 2;
constexpr size_t AR_GT = AR_L + (size_t)M * 3072 * 4;
constexpr size_t AR_RW = AR_GT + (size_t)M * 2048 * 4;
constexpr size_t AR_BON = AR_RW + (size_t)M * 16 * 384 * 4;
constexpr size_t AR_END = AR_BON + (size_t)M * 16 * 4;
constexpr size_t AR_HID = 0;
constexpr size_t AR_Y = 0;
constexpr size_t AR_YMIX = AR_Y + (size_t)M * 1024 * 4;
constexpr size_t AR_PPT = 0;
constexpr size_t AR_ZG = 0;
constexpr size_t WS_END = WS_AR + AR_END;
static_assert(AR_YMIX + (size_t)M * 2048 * 2 <= AR_A2, "Y/YMIX overlay inside Z");
constexpr int CW_TMO = 0, CW_BAR = 4096;
constexpr size_t O_Y = 0, O_P_WKV = 18874368, O_P_SHIFT = 19398656, O_P_H = 19425536, O_P_CONV = 19433728, O_P_CRE = 19458304, O_P_CIM = 19523840,
                 O_S_WKV = 19589376, O_S_SHIFT = 36366592, O_S_H = 37226752, O_S_CONV = 37488896, O_S_CRE = 38275328, O_S_CIM = 40372480, O_END = 42469632;
constexpr int RING_OFF = 0, RING_BYTES = 131072;
constexpr int LDSCTL_OFF = RING_BYTES, MISC_OFF = LDSCTL_OFF + 320;
constexpr int LDS_BYTES = 147456;
#define GAS __attribute__((address_space(1)))
#define LAS __attribute__((address_space(3)))
#define DI __device__ __forceinline__
typedef unsigned short bf16;
typedef unsigned v4u __attribute__((ext_vector_type(4)));
typedef unsigned v2u __attribute__((ext_vector_type(2)));
typedef float f32x4 __attribute__((ext_vector_type(4)));
typedef float f32x2 __attribute__((ext_vector_type(2)));
typedef short bf16x8 __attribute__((ext_vector_type(8)));
typedef GAS unsigned gu32;
#define RLX_AGENT __ATOMIC_RELAXED, __HIP_MEMORY_SCOPE_AGENT
#define LDS_WAIT() asm volatile("s_waitcnt lgkmcnt(0)" ::: "memory")
#define VM_WAIT() asm volatile("s_waitcnt vmcnt(0)" ::: "memory")
DI unsigned f2bf(float f) { unsigned u = __builtin_bit_cast(unsigned, f); return (u + 0x7fffu + ((u >> 16) & 1u)) >> 16; }
DI unsigned pk2(float lo, float hi) { return f2bf(lo) | (f2bf(hi) << 16); }
DI float bf_lo(unsigned w) { return __uint_as_float(w << 16); }
DI float bf_hi(unsigned w) { return __uint_as_float(w & 0xffff0000u); }
DI float wave_sum(float v) {
#pragma unroll
    for (int o = 1; o < 64; o <<= 1) v += __shfl_xor(v, o);
    return v;
}
template <int CTRL> DI float dpp_mov(float v) { return __builtin_bit_cast(float, __builtin_amdgcn_update_dpp(0, __builtin_bit_cast(int, v), CTRL, 0xf, 0xf, true)); }
DI float sum16(float s) {
    s += dpp_mov<0xB1>(s); s += dpp_mov<0x4E>(s); s += dpp_mov<0x141>(s); s += dpp_mov<0x140>(s); return s;
}
DI float sigmoid_acc(float x) { return 1.0f / (1.0f + expf(-x)); }
DI float gelu_tanh(float x) { const float z = 1.5957691216f * (x + 0.044715f * x * x * x); return x / (1.0f + __expf(-z)); }
DI float softplus_acc(float x) { return x > 20.f ? x : log1pf(expf(x)); }
#define XB_TMO      128
#define XB_XCNT(j)  (256  + 64 * (j))
#define XB_XSUB(j)  (1280 + 64 * (j))
#define XB_XGEN(j)  (2304 + 64 * (j))
#define XB_TOP      3328
#define XB_TOPGEN   3392
#define XCD_BAR_WORDS 3456
#define XB_SPIN_CAP (1u << 18)

__device__ __forceinline__ unsigned xb_ld(unsigned* p)              { return __hip_atomic_load(p, __ATOMIC_RELAXED, __HIP_MEMORY_SCOPE_AGENT); }
__device__ __forceinline__ unsigned xb_add(unsigned* p, unsigned v) { return __hip_atomic_fetch_add(p, v, __ATOMIC_RELAXED, __HIP_MEMORY_SCOPE_AGENT); }
__device__ __forceinline__ unsigned xb_xcc_id() { return (unsigned)__builtin_amdgcn_s_getreg((3 << 11) | 20) & 0xFu; }
#define XB_SPIN(cond, bar) do { unsigned _sp = 0; while (cond) { __builtin_amdgcn_s_sleep(1); \
    if ((++_sp & 255u) == 0u) { if (xb_ld(&(bar)[XB_TMO])) break; if (_sp > XB_SPIN_CAP) { atomicAdd(&(bar)[XB_TMO], 1u); break; } } } } while (0)

struct XcdBarrier {
    unsigned* bar; unsigned x;
    volatile LAS unsigned* st;
};

__device__ __forceinline__ XcdBarrier xcd_barrier_post(unsigned* bar, volatile LAS unsigned* st) {
    XcdBarrier b; b.bar = bar; b.x = xb_xcc_id(); b.st = st;
    if (threadIdx.x == 0) (void)xb_add(&bar[XB_XCNT(b.x)], 1u);
    return b;
}
__device__ __forceinline__ void xcd_barrier_complete(unsigned* bar, unsigned x, unsigned& nloc, unsigned& nx) {
    const unsigned G = gridDim.x * gridDim.y * gridDim.z;
    unsigned sum, cnt, mine, sp = 0u;
    for (;;) {
        sum = 0u; cnt = 0u; mine = 0u;
#pragma unroll
        for (unsigned j = 0; j < 16; ++j) { const unsigned c = xb_ld(&bar[XB_XCNT(j)]); sum += c; cnt += (c > 0u) ? 1u : 0u; mine = (j == x) ? c : mine; }
        if (sum == G) break;
        __builtin_amdgcn_s_sleep(1);
        if ((++sp & 255u) == 0u) { if (xb_ld(&bar[XB_TMO])) break; if (sp > XB_SPIN_CAP) { atomicAdd(&bar[XB_TMO], 1u); break; } }
    }
    nloc = mine > 0u ? mine : 1u; nx = cnt > 0u ? cnt : 1u;
}

__device__ __forceinline__ void xcd_barrier(const XcdBarrier& b) {
    asm volatile("s_waitcnt vmcnt(0)" ::: "memory");
    __syncthreads();
    if (threadIdx.x == 0) {
        unsigned* bar = b.bar;
        __builtin_amdgcn_s_waitcnt(0);
        unsigned nloc = b.st[0], nx = b.st[1];
        if (nloc == 0u) { xcd_barrier_complete(bar, b.x, nloc, nx); b.st[0] = nloc; b.st[1] = nx; }
        const unsigned old = xb_add(&bar[XB_XSUB(b.x)], 1u);
        const unsigned gen = old / nloc;
        if (old + 1u == (gen + 1u) * nloc) {
            __builtin_amdgcn_fence(__ATOMIC_RELEASE, "agent");
            asm volatile("s_waitcnt vmcnt(0)" ::: "memory");
            const unsigned og = xb_add(&bar[XB_TOP], 1u);
            const unsigned tg = og / nx;
            if (og + 1u == (tg + 1u) * nx) xb_add(&bar[XB_TOPGEN], 1u);
            else XB_SPIN(xb_ld(&bar[XB_TOPGEN]) == tg, bar);
            __builtin_amdgcn_fence(__ATOMIC_ACQUIRE, "agent");
            xb_add(&bar[XB_XGEN(b.x)], 1u);
            asm volatile("s_waitcnt vmcnt(0)" ::: "memory");
        } else {
            XB_SPIN(xb_ld(&bar[XB_XGEN(b.x)]) == gen, bar);
            __builtin_amdgcn_fence(__ATOMIC_ACQUIRE, "agent");
            asm volatile("s_waitcnt vmcnt(0)" ::: "memory");
        }
    }
    __syncthreads();
}
struct Args { const float* in[53]; float* out; unsigned char* ws; };
struct KArgsT { const GAS float* in_[53]; GAS float* out_; GAS unsigned char* ws_; };
typedef const __attribute__((address_space(4))) KArgsT* KA;
#define INP(k) ((const float*)a->in_[k])
#define OUTP ((float*)a->out_)
#define WSP ((unsigned char*)a->ws_)
#define FRESH(p) asm volatile("" : "+s"(p))
struct Frame {
    LAS unsigned char* lds;
    volatile LAS unsigned* MISC;
    gu32* ctl;
    int tid, lane, wave, vcu, G, gw, NGW;
};
DI void refresh(Frame& F) { int t = threadIdx.x; asm volatile("" : "+v"(t)); F.tid = t; F.lane = t & 63; F.wave = __builtin_amdgcn_readfirstlane(t >> 6); F.gw = F.vcu * NWAVES + F.wave; }

DI void tr_item(const float* W, int ldw, int k0, int n0, bf16* WT, int dstK, int drow0, const float* ksc, int lane) {
    const int c = lane >> 3, q = lane & 7; const float* src = W + (size_t)(k0 + 8 * c) * ldw + n0 + 4 * q; f32x4 v[8];
#pragma unroll
    for (int i = 0; i < 8; ++i) v[i] = *(const f32x4*)(src + (size_t)i * ldw);
    if (ksc) { const f32x4 s0 = *(const f32x4*)(ksc + k0 + 8 * c), s1 = *(const f32x4*)(ksc + k0 + 8 * c + 4);
#pragma unroll
        for (int i = 0; i < 4; ++i) { v[i] = v[i] * s0[i]; v[4 + i] = v[4 + i] * s1[i]; } }
    bf16* d = WT + (size_t)(drow0 + 4 * q) * dstK + k0 + 8 * c;
#pragma unroll
    for (int e = 0; e < 4; ++e) *(v4u*)(d + (size_t)e * dstK) = (v4u){pk2(v[0][e], v[1][e]), pk2(v[2][e], v[3][e]), pk2(v[4][e], v[5][e]), pk2(v[6][e], v[7][e])};
}
DI void s5_coef(KA a, int j, int g, int p, float& abr, float& abi, float& fr, float& fi) {
    const int ix = (j * 128 + g) * 64 + p; const float are = INP(42)[ix], aim = INP(43)[ix], dt = expf(INP(44)[j * 128 + g]);
    const float mag = expf(dt * are); abr = mag * cosf(dt * aim); abi = mag * sinf(dt * aim);
    const float den = are * are + aim * aim; fr = ((abr - 1.0f) * are + abi * aim) / den; fi = (abi * are - (abr - 1.0f) * aim) / den;
}
DI void p0_prologue(KA a, Frame& F) {
    unsigned char* ws = WSP;
    constexpr int NA = 16 * 5632, NB = 8 * 5632, NC = 8 * 2048, ND = 2 * 5408, NE = 4 * 256, NIT = NA + NB + NC + ND + NE;
    for (int it = F.gw; it < NIT; it += F.NGW) {
        int r = it; const float* W; const float* ksc = nullptr; bf16* dst; int ldw, k0, n0, dstK, drow0;
        if (r < NA) { const int mtx = r / 5632, rr = r % 5632, lf = mtx >> 1, gu = mtx & 1, l = lf >> 1, f = lf & 1, kb = rr / 176, nb = rr % 176;
            const float* src = f ? (gu ? INP(17) : INP(16)) : (gu ? INP(12) : INP(11));
            W = src + (size_t)l * D * FF; ldw = FF; k0 = kb * 64; n0 = nb * 32; dst = (bf16*)(ws + WS_WGU + (size_t)lf * SZ_WGU); dstK = D; drow0 = (n0 >> 7) * 256 + (n0 & 127) + gu * 128 - n0;
            ksc = (f ? INP(15) : INP(10)) + l * D; }
        else if ((r -= NA) < NB) { const int mtx = r / 5632, rr = r % 5632, l = mtx >> 1, f = mtx & 1, kb = rr / 64, nb = rr % 64;
            W = (f ? INP(18) : INP(13)) + (size_t)l * FF * D; ldw = D; k0 = kb * 64; n0 = nb * 32; dst = (bf16*)(ws + WS_WD + (size_t)mtx * SZ_WD); dstK = FF; drow0 = 0; }
        else if ((r -= NB) < NC) { const int mtx = r / 2048, rr = r % 2048, kb = rr / 64, nb = rr % 64;
            if (mtx < 4) { W = INP(20) + (size_t)mtx * D * D; dst = (bf16*)(ws + WS_PLEG + (size_t)mtx * SZ_SQ); ksc = INP(19) + mtx * D; }
            else if (mtx < 6) { W = INP(41) + (size_t)(mtx - 4) * D * D; dst = (bf16*)(ws + WS_WOUT + (size_t)(mtx - 4) * SZ_SQ); }
            else { W = INP(50) + (size_t)(mtx - 6) * D * D; dst = (bf16*)(ws + WS_WGLU + (size_t)(mtx - 6) * SZ_SQ); }
            ldw = D; k0 = kb * 64; n0 = nb * 32; dstK = D; drow0 = 0; }
        else if ((r -= NC) < ND) { const int j = r / 5408, rr = r % 5408, kb = rr / 169, nb = rr % 169;
            W = INP(22) + (size_t)j * D * 5408; ldw = 5408; k0 = kb * 64; n0 = nb * 32; dst = (bf16*)(ws + WS_WIN + (size_t)j * SZ_WIN); dstK = D; drow0 = 0; ksc = INP(14) + (2 * j) * D; }
        else { r -= ND; const int l = r / 256, rr = r % 256, kb = rr / 64, nb = rr % 64;
            W = INP(21) + (size_t)l * 256 * D; ldw = D; k0 = kb * 64; n0 = nb * 32; dst = (bf16*)(ws + WS_PLEP + (size_t)l * SZ_PLEP); dstK = 256; drow0 = 0; }
        tr_item(W, ldw, k0, n0, dst, dstK, n0 + drow0, ksc, F.lane);
    }
    const int gt = F.gw * 64 + F.lane, NGT = F.NGW * 64;
    for (int i = gt; i < 2 * 224 * 256; i += NGT) { const int j = i / (224 * 256), r = i % (224 * 256); *(v4u*)(ws + WS_WIN + (size_t)j * SZ_WIN + ((size_t)5408 * D + (size_t)r * 8) * 2) = (v4u){0u, 0u, 0u, 0u}; }
    for (int i = gt; i < 2 * 3072 * 48; i += NGT) { const int j = i / (3072 * 48), r = i % (3072 * 48), n = r / 48, kv = (r % 48) * 8; float v[8];
#pragma unroll
        for (int e = 0; e < 8; ++e) { const int k = kv + e; float x = 0.f;
            if (n < 1024) { if (k < 64) x = INP(25)[((size_t)j * 64 + k) * 1024 + n]; }
            else if (n < 2048) { if (k >= 64 && k < 128) x = INP(27)[((size_t)j * 64 + (k - 64)) * 1024 + (n - 1024)]; }
            else { if (k >= 128 && k < 288) x = INP(28)[((size_t)j * 160 + (k - 128)) * 1024 + (n - 2048)]; }
            v[e] = x; }
        *(v4u*)(ws + WS_WLORA + (size_t)j * SZ_WLORA + ((size_t)n * 384 + kv) * 2) = (v4u){pk2(v[0], v[1]), pk2(v[2], v[3]), pk2(v[4], v[5]), pk2(v[6], v[7])}; }
    for (int i = gt; i < 2 * 2048 * 128; i += NGT) { const int j = i / (2048 * 128), r = i % (2048 * 128), n = r / 128, kv = (r % 128) * 8; const int blk = (n & 1023) >> 6, ko = n & 63; float v[8];
        const float* src = (n < 1024 ? INP(36) : INP(38)) + ((size_t)j * 16 + blk) * 4096;
#pragma unroll
        for (int e = 0; e < 8; ++e) { const int k = kv + e; v[e] = ((k >> 6) == blk) ? src[(k & 63) * 64 + ko] : 0.f; }
        *(v4u*)(ws + WS_WGATE + (size_t)j * SZ_WGATE + ((size_t)n * 1024 + kv) * 2) = (v4u){pk2(v[0], v[1]), pk2(v[2], v[3]), pk2(v[4], v[5]), pk2(v[6], v[7])}; }
    for (int i = gt; i < 2 * 128 * 64; i += NGT) { const int j = i / 8192, g = (i % 8192) / 64, p = i % 64; float abr, abi, fr, fi; s5_coef(a, j, g, p, abr, abi, fr, fi);
        *(f32x2*)(ws + WS_S5AB + (size_t)i * 8) = (f32x2){abr, abi}; }
    for (int i = gt; i < 2 * 128 * 8 * 64; i += NGT) { const int j = i / 65536, g = (i / 512) % 128, nb = (i / 64) % 8, ln = i % 64, n = nb * 16 + (ln & 15), p = n >> 1, part = n & 1, quad = ln >> 4; float v[8];
        float abr, abi, fr, fi; s5_coef(a, j, g, p, abr, abi, fr, fi);
#pragma unroll
        for (int e = 0; e < 8; ++e) { const int k = quad * 8 + e; float x = 0.f;
            if (k < 16) { const size_t ix = (((size_t)j * 128 + g) * 64 + p) * 16 + k; const float br = INP(45)[ix], bi = INP(46)[ix]; const float bb = part ? (fr * bi + fi * br) : (fr * br - fi * bi); x = bb * INP(14)[(2 * j + 1) * D + g * 16 + k]; }
            v[e] = x; }
        *(v4u*)(ws + WS_S5BUB + (size_t)i * 16) = (v4u){pk2(v[0], v[1]), pk2(v[2], v[3]), pk2(v[4], v[5]), pk2(v[6], v[7])}; }
    for (int i = gt; i < 2 * 128 * 4 * 64; i += NGT) { const int j = i / 32768, g = (i / 256) % 128, ks = (i / 64) % 4, ln = i % 64, c = ln & 15, quad = ln >> 4; float v[8];
#pragma unroll
        for (int e = 0; e < 8; ++e) { const int k = ks * 32 + quad * 8 + e, p = k >> 1, part = k & 1; const size_t ix = (((size_t)j * 128 + g) * 16 + c) * 64 + p; v[e] = part ? -INP(48)[ix] : INP(47)[ix]; }
        *(v4u*)(ws + WS_S5CB + (size_t)i * 16) = (v4u){pk2(v[0], v[1]), pk2(v[2], v[3]), pk2(v[4], v[5]), pk2(v[6], v[7])}; }
    for (int i = gt; i < 2 * 2048; i += NGT) { const int j = i / 2048, c = i % 2048; ((float*)(ws + WS_S5DG))[i] = INP(49)[i] * INP(14)[(2 * j + 1) * D + c]; }
    for (int i = gt; i < 4 * M * 32; i += NGT) { const int l = i / (M * 32), r = i % (M * 32), m = r / 32, kv = (r % 32) * 8;
        const float* src = (m < MPR) ? INP(8) + ((size_t)l * MPR + m) * 256 + kv : INP(9) + ((size_t)l * 1024 + (m - MPR)) * 256 + kv;
        const f32x4 x0 = *(const f32x4*)src, x1 = *(const f32x4*)(src + 4);
        *(v4u*)(ws + WS_PB + (size_t)i * 16) = (v4u){pk2(x0[0], x0[1]), pk2(x0[2], x0[3]), pk2(x1[0], x1[1]), pk2(x1[2], x1[3])}; }
    float* X = (float*)(ws + WS_X); bf16* XB = (bf16*)(ws + WS_XB); float* ssq = (float*)(ws + WS_SSQ);
    for (int m = F.gw; m < M; m += F.NGW) { const float* src = (m < MPR) ? INP(0) + (size_t)m * D : INP(1) + (size_t)(m - MPR) * D; float s = 0.f;
#pragma unroll
        for (int i = 0; i < 8; ++i) { const int c = F.lane * 4 + 256 * i; const f32x4 v = *(const f32x4*)(src + c); *(f32x4*)(X + (size_t)m * D + c) = v; *(v2u*)(XB + (size_t)m * D + c) = (v2u){pk2(v[0], v[1]), pk2(v[2], v[3])};
            s += (v[0] * v[0] + v[1] * v[1]) + (v[2] * v[2] + v[3] * v[3]); }
        s = wave_sum(s); if (F.lane == 0) ssq[m] = s; }
}
constexpr size_t RW_PROMPT = (size_t)64 * 2048 * 384;
DI size_t rw_off(bool smp, int b, int h, int t) { return smp ? RW_PROMPT + ((size_t)(b * 16 + h) * 8 + t) * 384 : ((size_t)(b * 16 + h) * 2048 + t) * 384; }
DI void mix_pass_a(KA a, Frame& F, int j) {
    unsigned char* ar = WSP + WS_AR; const float* Z = (const float*)(ar + AR_Z); bf16* A2 = (bf16*)(ar + AR_A2); bf16* XCB = (bf16*)(ar + AR_XCB);
    const float* mu = INP(23) + j * COLSA; const float* cw = INP(34) + j * 4096; const float* cb = INP(35) + j * 1024; const int lane = F.lane;
    for (int m = F.gw; m < M; m += F.NGW) {
        const bool smp = m >= MPR; const int b = smp ? (m - MPR) >> 3 : m >> 11, t = smp ? (m - MPR) & 7 : m & 2047, T = smp ? TS : TP;
        const float* zr = Z + (size_t)m * ZP; const float* zp = t > 0 ? zr - ZP : (smp ? INP(3) + ((size_t)j * NBS + b) * COLSA : nullptr);
#pragma unroll
        for (int i = 0; i < 6; ++i) { const int c = lane + 64 * i; float v = 0.f;
            if (c < 288) { const int cc = 3072 + c; const float z = zr[cc], p = zp ? zp[cc] : 0.f, zs = z + (p - z) * mu[cc]; v = c < 64 ? tanhf(zs) : (c < 128 ? zs : sigmoid_acc(zs)); }
            A2[(size_t)m * 384 + c] = (bf16)f2bf(v); }
#pragma unroll
        for (int i = 0; i < 4; ++i) { const int ch = lane * 4 + 256 * i; f32x4 acc = *(const f32x4*)(cb + ch);
#pragma unroll
            for (int jj = 0; jj < 4; ++jj) { const int s = t - 3 + jj; f32x4 xin = (f32x4){0.f, 0.f, 0.f, 0.f};
                if (s >= 0) xin = *(const f32x4*)(zr + (ptrdiff_t)(s - t) * ZP + COLSA + ch);
                else if (smp) xin = *(const f32x4*)(INP(5) + (((size_t)j * NBS + b) * 3 + (3 + s)) * 1024 + ch);
                acc += xin * *(const f32x4*)(cw + jj * 1024 + ch); }
            *(v2u*)(XCB + (size_t)m * 1024 + ch) = (v2u){pk2(acc[0], acc[1]), pk2(acc[2], acc[3])}; }
        if (t == T - 1) { float* dst = OUTP + (smp ? O_S_SHIFT + ((size_t)j * NBS + b) * COLSA : O_P_SHIFT + ((size_t)j * NBP + b) * COLSA);
            for (int c = lane * 4; c < COLSA; c += 256) *(f32x4*)(dst + c) = *(const f32x4*)(zr + c); }
        if (t >= T - 3) { const int r = t - (T - 3); float* dst = OUTP + (smp ? O_S_CONV + (((size_t)j * NBS + b) * 3 + r) * 1024 : O_P_CONV + (((size_t)j * NBP + b) * 3 + r) * 1024);
#pragma unroll
            for (int i = 0; i < 4; ++i) { const int ch = lane * 4 + 256 * i; *(f32x4*)(dst + ch) = *(const f32x4*)(zr + COLSA + ch); } }
    }
}
DI void mix_pass_b(KA a, Frame& F, int j) {
    unsigned char* ar = WSP + WS_AR; const float* Z = (const float*)(ar + AR_Z); const bf16* XCB = (const bf16*)(ar + AR_XCB); float* L = (float*)(ar + AR_L); float* GT = (float*)(ar + AR_GT);
    float* RW = (float*)(ar + AR_RW); float* BON = (float*)(ar + AR_BON);
    const float* mu = INP(23) + j * COLSA; const float* w0 = INP(24) + j * 1024; const float* a0 = INP(26) + j * 1024; const float* kka = INP(29) + j * 1024; const float* kaa = INP(30) + j * 1024; const float* rk = INP(31) + j * 1024;
    const float* ba = INP(37) + j * 1024; const float* bx = INP(39) + j * 1024; const float* lam = INP(40) + j * 1024; const int lane = F.lane;
    for (int m = F.gw; m < M; m += F.NGW) {
        const bool smp = m >= MPR; const int b = smp ? (m - MPR) >> 3 : m >> 11, t = smp ? (m - MPR) & 7 : m & 2047;
        const float* zr = Z + (size_t)m * ZP; const float* zp = t > 0 ? zr - ZP : (smp ? INP(3) + ((size_t)j * NBS + b) * COLSA : nullptr);
        float* Lr = L + (size_t)m * 3072;
        for (int h = 0; h < 16; ++h) { const int c = h * 64 + lane;
            const float zr_ = zr[c], zk_ = zr[1024 + c], zv_ = zr[2048 + c];
            const float pr = zp ? zp[c] : 0.f, pk = zp ? zp[1024 + c] : 0.f, pv = zp ? zp[2048 + c] : 0.f;
            const float r = zr_ + (pr - zr_) * mu[c], k = zk_ + (pk - zk_) * mu[1024 + c], v = zv_ + (pv - zv_) * mu[2048 + c];
            const float wl = -softplus_acc(-(w0[c] + Lr[c])) - 0.5f, w = expf(-expf(wl));
            const float aa = sigmoid_acc(a0[c] + Lr[1024 + c]);
            float kk = k * kka[c]; const float n2 = wave_sum(kk * kk); kk = kk / fmaxf(sqrtf(n2), 1e-12f);
            const float kp = k * (1.0f + (aa - 1.0f) * kaa[c]);
            const float bon = wave_sum(r * kp * rk[c]);
            float* p = RW + rw_off(smp, b, h, t);
            p[lane] = r; p[64 + lane] = w; p[128 + lane] = kp; p[192 + lane] = kk; p[256 + lane] = kk * aa; p[320 + lane] = v;
            if (lane == 0) BON[(size_t)m * 16 + h] = bon; }
#pragma unroll
        for (int i = 0; i < 4; ++i) { const int ch = lane * 4 + 256 * i; float* gp = GT + (size_t)m * 2048 + ch;
            const f32x4 gr = *(const f32x4*)gp, gi = *(const f32x4*)(gp + 1024), zg = *(const f32x4*)(zr + 4384 + ch); const v2u xw = *(const v2u*)(XCB + (size_t)m * 1024 + ch);
            const float xc[4] = {bf_lo(xw[0]), bf_hi(xw[0]), bf_lo(xw[1]), bf_hi(xw[1])}; f32x4 av, bv, gb;
#pragma unroll
            for (int e = 0; e < 4; ++e) { const float g_r = sigmoid_acc(gr[e] + ba[ch + e]), g_i = sigmoid_acc(gi[e] + bx[ch + e]); const float la = -8.0f * g_r * softplus_acc(-lam[ch + e]);
                av[e] = expf(la); bv[e] = sqrtf(-expm1f(2.0f * la)) * (g_i * xc[e]); gb[e] = gelu_tanh(zg[e]); }
            *(f32x4*)gp = av; *(f32x4*)(gp + 1024) = bv; *(f32x4*)(Lr + ch) = gb; }
    }
}
DI void mix_pass_c(KA a, Frame& F, int j) {
    unsigned char* ar = WSP + WS_AR; const float* Y = (const float*)(ar + AR_Y); bf16* YMIX = (bf16*)(ar + AR_YMIX); const float* L = (const float*)(ar + AR_L); const float* RW = (const float*)(ar + AR_RW); const float* BON = (const float*)(ar + AR_BON);
    const float* lg = INP(32) + j * 1024; const float* lb = INP(33) + j * 1024; const int lane = F.lane;
    for (int m = F.gw; m < M; m += F.NGW) {
        const bool smp = m >= MPR; const int b = smp ? (m - MPR) >> 3 : m >> 11, t = smp ? (m - MPR) & 7 : m & 2047;
        for (int h = 0; h < 16; ++h) { const int c = h * 64 + lane; const float y = Y[(size_t)m * 1024 + c];
            const float mean = wave_sum(y) * (1.0f / 64.0f), d = y - mean, var = wave_sum(d * d) * (1.0f / 64.0f);
            const float yn = d * (1.0f / sqrtf(var + GN_EPS)) * lg[c] + lb[c];
            const float v = RW[rw_off(smp, b, h, t) + 320 + lane], g = L[(size_t)m * 3072 + 2048 + c];
            YMIX[(size_t)m * 2048 + c] = (bf16)f2bf((yn + BON[(size_t)m * 16 + h] * v) * g); }
    }
}
DI void rwkv_job(Frame& F, const float* rw, int T, const float* s_in, float* s_out, float* Yp, int half) {
    LAS float* lds = (LAS float*)F.lds; LAS float* ybuf = lds + 2 * 6144;
    const int tid = F.tid, lane = F.lane, q = lane & 15, rl = F.wave * 4 + (lane >> 4), i = half * 32 + rl;
    f32x4 S = s_in ? *(const f32x4*)(s_in + i * 64 + 4 * q) : (f32x4){0.f, 0.f, 0.f, 0.f};
    const int nch = (T + 15) >> 4; f32x4 pre[3];
    { const int ns = T < 16 ? T : 16;
#pragma unroll
      for (int k = 0; k < 3; ++k) { const int idx = (tid + 512 * k) * 4; if (idx < ns * 384) *(LAS f32x4*)(lds + idx) = *(const f32x4*)(rw + idx); } }
    __syncthreads();
    for (int c = 0; c < nch; ++c) {
        const int cur = c & 1, ns = (T - 16 * c) < 16 ? (T - 16 * c) : 16; const bool more = (c + 1 < nch); const int nsn = more ? ((T - 16 * (c + 1)) < 16 ? (T - 16 * (c + 1)) : 16) : 0;
        if (more) { const float* src = rw + (size_t)(c + 1) * 6144;
#pragma unroll
            for (int k = 0; k < 3; ++k) { const int idx = (tid + 512 * k) * 4; pre[k] = (idx < nsn * 384) ? *(const f32x4*)(src + idx) : (f32x4){0.f, 0.f, 0.f, 0.f}; } }
        LAS float* buf = lds + cur * 6144;
        f32x4 r4 = *(LAS f32x4*)(buf + 4 * q), w4 = *(LAS f32x4*)(buf + 64 + 4 * q), k4 = *(LAS f32x4*)(buf + 128 + 4 * q), kk4 = *(LAS f32x4*)(buf + 192 + 4 * q), b4 = *(LAS f32x4*)(buf + 256 + 4 * q); float v = buf[320 + i];
        for (int tt = 0; tt < ns; ++tt) { const int tn = (tt + 1 < ns) ? tt + 1 : tt; LAS float* bs = buf + tn * 384;
            const f32x4 r4n = *(LAS f32x4*)(bs + 4 * q), w4n = *(LAS f32x4*)(bs + 64 + 4 * q), k4n = *(LAS f32x4*)(bs + 128 + 4 * q), kk4n = *(LAS f32x4*)(bs + 192 + 4 * q), b4n = *(LAS f32x4*)(bs + 256 + 4 * q); const float vn = bs[320 + i];
            float sa = -((S[0] * kk4[0] + S[1] * kk4[1]) + (S[2] * kk4[2] + S[3] * kk4[3]));
            const f32x4 pre = S * w4 + v * k4;
            sa = sum16(sa);
            S = pre + sa * b4;
            float y = (S[0] * r4[0] + S[1] * r4[1]) + (S[2] * r4[2] + S[3] * r4[3]); y = sum16(y);
            if (q == 0) ybuf[tt * 32 + rl] = y;
            r4 = r4n; w4 = w4n; k4 = k4n; kk4 = kk4n; b4 = b4n; v = vn; }
        __syncthreads();
        { const int tt = tid >> 5, rr = tid & 31; if (tt < ns) Yp[(size_t)(16 * c + tt) * 1024 + half * 32 + rr] = ybuf[tid]; }
        if (more) { LAS float* nb = lds + (cur ^ 1) * 6144;
#pragma unroll
            for (int k = 0; k < 3; ++k) { const int idx = (tid + 512 * k) * 4; if (idx < nsn * 384) *(LAS f32x4*)(nb + idx) = pre[k]; } }
        __syncthreads();
    }
    *(f32x4*)(s_out + i * 64 + 4 * q) = S;
}
DI void scan_phase(KA a, Frame& F, int j) {
    unsigned char* ar = WSP + WS_AR; const float* RW = (const float*)(ar + AR_RW); float* Y = (float*)(ar + AR_Y); bf16* YMIX = (bf16*)(ar + AR_YMIX); const float* GT = (const float*)(ar + AR_GT); const float* L = (const float*)(ar + AR_L);
    const int nA = F.G / 2;
    if (F.vcu < nA) {
        for (int pj = F.vcu; pj < 128; pj += nA) { const int half = pj & 1, bh = pj >> 1, b = bh >> 4, h = bh & 15;
            rwkv_job(F, RW + (size_t)bh * 2048 * 384, TP, nullptr, OUTP + O_P_WKV + (((size_t)j * NBP + b) * 16 + h) * 4096, Y + (size_t)(b * TP) * 1024 + h * 64, half); }
    } else {
        const int w2 = F.vcu - nA, n2 = F.G - nA; LAS float* sA = (LAS float*)F.lds; LAS float* sB = sA + 512;
        for (int lj = w2; lj < 128; lj += n2) { const int b = lj >> 5, ch = (lj & 31) * 32 + (F.tid & 31), seg = F.tid >> 5; const size_t m0 = (size_t)b * TP + seg * 128;
            float A = 1.f, Bv = 0.f;
#pragma unroll 8
            for (int t = 0; t < 128; ++t) { const float a_ = GT[(m0 + t) * 2048 + ch], b_ = GT[(m0 + t) * 2048 + 1024 + ch]; Bv = a_ * Bv + b_; A *= a_; }
            sA[F.tid] = A; sB[F.tid] = Bv; __syncthreads();
            float hh = 0.f; for (int s = 0; s < seg; ++s) hh = sA[s * 32 + (F.tid & 31)] * hh + sB[s * 32 + (F.tid & 31)];
#pragma unroll 8
            for (int t = 0; t < 128; ++t) { const float a_ = GT[(m0 + t) * 2048 + ch], b_ = GT[(m0 + t) * 2048 + 1024 + ch]; hh = a_ * hh + b_; YMIX[(m0 + t) * 2048 + 1024 + ch] = (bf16)f2bf(hh * L[(m0 + t) * 3072 + ch]); }
            if (seg == 15) OUTP[O_P_H + ((size_t)j * NBP + b) * 1024 + ch] = hh;
            __syncthreads(); }
        for (int sj = w2; sj < 256; sj += n2) { const int idx = sj * 512 + F.tid, b = idx >> 10, ch = idx & 1023; float hh = INP(4)[((size_t)j * NBS + b) * 1024 + ch];
#pragma unroll
            for (int t = 0; t < 8; ++t) { const size_t m = MPR + b * 8 + t; hh = GT[m * 2048 + ch] * hh + GT[m * 2048 + 1024 + ch]; YMIX[m * 2048 + 1024 + ch] = (bf16)f2bf(hh * L[m * 3072 + ch]); }
            OUTP[O_S_H + ((size_t)j * NBS + b) * 1024 + ch] = hh; }
        for (int sj = w2; sj < 4096; sj += n2) { const int half = sj & 1, bh = sj >> 1, b = bh >> 4, h = bh & 15; const size_t so = (((size_t)j * NBS + b) * 16 + h) * 4096;
            rwkv_job(F, RW + RW_PROMPT + (size_t)bh * 8 * 384, TS, INP(2) + so, OUTP + O_S_WKV + so, Y + (size_t)(MPR + b * 8) * 1024 + h * 64, half); }
    }
}
template <bool SMP> DI void s5_job(KA a, Frame& F, int j, int g, size_t m0, int nchunks, int b0, const bf16* XB, const float* ssq) {
    unsigned char* ws = WSP; const int lane = F.lane, t16 = lane & 15, quad = lane >> 4;
    LAS float* BUc = (LAS float*)(F.lds + F.wave * 12800); LAS unsigned* Hc = (LAS unsigned*)(F.lds + F.wave * 12800 + 8448);
    bf16* ZG = (bf16*)(ws + WS_AR + AR_ZG);
    bf16x8 bub[8], cb[4];
#pragma unroll
    for (int nb = 0; nb < 8; ++nb) bub[nb] = *(const bf16x8*)(ws + WS_S5BUB + ((((size_t)j * 128 + g) * 8 + nb) * 64 + lane) * 16);
#pragma unroll
    for (int ks = 0; ks < 4; ++ks) cb[ks] = *(const bf16x8*)(ws + WS_S5CB + ((((size_t)j * 128 + g) * 4 + ks) * 64 + lane) * 16);
    const f32x2 ab = *(const f32x2*)(ws + WS_S5AB + (((size_t)j * 128 + g) * 64 + lane) * 8); const float ar_ = ab[0], ai_ = ab[1];
    const float dg = ((const float*)(ws + WS_S5DG))[j * 2048 + g * 16 + t16];
    float hr = 0.f, hi = 0.f;
    bf16x8 afn; float ssn[4]; bf16 xbn[4];
#define S5_LOAD(mc_) do { afn = (bf16x8){0, 0, 0, 0, 0, 0, 0, 0}; if (quad < 2) afn = *(const bf16x8*)(XB + ((mc_) + t16) * 2048 + g * 16 + quad * 8); \
        _Pragma("unroll") for (int jj = 0; jj < 4; ++jj) { ssn[jj] = ssq[(mc_) + quad * 4 + jj]; xbn[jj] = XB[((mc_) + quad * 4 + jj) * 2048 + g * 16 + t16]; } } while (0)
    S5_LOAD(m0);
    for (int c = 0; c < nchunks; ++c) { const size_t mc = m0 + (size_t)c * 16;
        const bf16x8 af = afn; float rs[4], xbv[4];
#pragma unroll
        for (int jj = 0; jj < 4; ++jj) { rs[jj] = __builtin_amdgcn_rsqf(ssn[jj] * (1.0f / 2048.0f) + 1e-6f); xbv[jj] = __uint_as_float((unsigned)xbn[jj] << 16); }
        if (c + 1 < nchunks) S5_LOAD(mc + 16);
#pragma unroll
        for (int nb = 0; nb < 8; ++nb) { const f32x4 d = __builtin_amdgcn_mfma_f32_16x16x32_bf16(af, bub[nb], (f32x4){0.f, 0.f, 0.f, 0.f}, 0, 0, 0);
#pragma unroll
            for (int jj = 0; jj < 4; ++jj) BUc[(quad * 4 + jj) * 132 + nb * 16 + t16] = d[jj] * rs[jj]; }
        LDS_WAIT(); asm volatile("" ::: "memory");
#pragma unroll
        for (int tt = 0; tt < 16; ++tt) {
            if (SMP && (tt & 7) == 0) { const size_t si = (((size_t)j * NBS + (b0 + 2 * c + (tt >> 3))) * 128 + g) * 64 + lane; hr = INP(6)[si]; hi = INP(7)[si]; }
            const f32x2 bu = *(LAS f32x2*)(BUc + tt * 132 + 2 * lane);
            const float nr = ar_ * hr - ai_ * hi + bu[0], ni = ar_ * hi + ai_ * hr + bu[1]; hr = nr; hi = ni;
            Hc[tt * 68 + lane] = pg8::cvt_pk_bf16(hr, hi);
            if (SMP && (tt & 7) == 7) { const size_t si = (((size_t)j * NBS + (b0 + 2 * c + (tt >> 3))) * 128 + g) * 64 + lane; OUTP[O_S_CRE + si] = hr; OUTP[O_S_CIM + si] = hi; }
        }
        LDS_WAIT(); asm volatile("" ::: "memory");
        f32x4 acc = (f32x4){0.f, 0.f, 0.f, 0.f};
#pragma unroll
        for (int ks = 0; ks < 4; ++ks) { const bf16x8 ah = *(LAS bf16x8*)((LAS unsigned char*)Hc + t16 * 272 + ks * 64 + quad * 16); acc = __builtin_amdgcn_mfma_f32_16x16x32_bf16(ah, cb[ks], acc, 0, 0, 0); }
#pragma unroll
        for (int jj = 0; jj < 4; ++jj) { const size_t o = (mc + quad * 4 + jj) * 2048 + g * 16 + t16;
            ZG[o] = (bf16)f2bf(gelu_tanh(acc[jj] + dg * rs[jj] * xbv[jj])); }
        LDS_WAIT(); asm volatile("" ::: "memory");
    }
#undef S5_LOAD
    if (!SMP) { const int b = (int)(m0 >> 11); const size_t si = (((size_t)j * NBP + b) * 128 + g) * 64 + lane; OUTP[O_P_CRE + si] = hr; OUTP[O_P_CIM + si] = hi; }
}
DI void s5_phase(KA a, Frame& F, int j, const bf16* XB, const float* ssq) {
    if (F.wave < 2) { for (int jp = F.vcu * 2 + F.wave; jp < 512; jp += F.G * 2) { const int b = jp >> 7, g = jp & 127; s5_job<false>(a, F, j, g, (size_t)b * TP, 128, 0, XB, ssq); } }
    else { for (int js = F.vcu * 6 + (F.wave - 2); js < 1024; js += F.G * 6) { const int g = js >> 3, s = js & 7; s5_job<true>(a, F, j, g, (size_t)MPR + (size_t)s * 128, 8, 16 * s, XB, ssq); } }
}
DI void final_phase(KA a, Frame& F, const float* ssq) {
    const float* X = (const float*)(WSP + WS_X); const float* fn = INP(52);
    for (int m = F.gw; m < M; m += F.NGW) { const float rs = 1.0f / sqrtf(ssq[m] * (1.0f / 2048.0f) + 1e-6f);
#pragma unroll
        for (int i = 0; i < 8; ++i) { const int c = F.lane * 4 + 256 * i; *(f32x4*)(OUTP + (size_t)m * D + c) = *(const f32x4*)(X + (size_t)m * D + c) * rs * *(const f32x4*)(fn + c); } }
}
#define GEMM_SITE(EPI, AEXPR, BEXPR, NN, KK, ...) do { FRESH(a); unsigned char* ws = WSP; unsigned char* ar = ws + WS_AR; float* X = (float*)(ws + WS_X); float* SSQ = (float*)(ws + WS_SSQ); (void)ar; (void)X; (void)SSQ; \
        bf16* XBc = (bf16*)(ws + WS_XB + (size_t)xcur * ((size_t)M * D * 2)); bf16* XBn = (bf16*)(ws + WS_XB + (size_t)(xcur ^ 1) * ((size_t)M * D * 2)); (void)XBc; (void)XBn; \
        pg8::Gemm g_{(const bf16*)(AEXPR), (const bf16*)(BEXPR), M, NN, KK}; pg8::StaticOrder S_; S_.init(M, NN, F.G, (int)blockIdx.x); \
        EPI E_{__VA_ARGS__}; pg8::gemm_phase<EPI, pg8::StaticOrder, true, true>(F.lds + RING_OFF, g_, S_, E_); } while (0)
__global__ void __launch_bounds__(NWAVES * 64, 2) trunk_fwd(Args args_by_value) {
    extern __shared__ __attribute__((aligned(16))) unsigned char lds[];
    KA a = (KA)__builtin_amdgcn_kernarg_segment_ptr();
    Frame F;
    F.lds = (LAS unsigned char*)lds; F.MISC = (volatile LAS unsigned*)(F.lds + MISC_OFF);
    F.tid = threadIdx.x; F.lane = F.tid & 63; F.wave = __builtin_amdgcn_readfirstlane(F.tid >> 6);
    F.G = gridDim.x; { const int bx = blockIdx.x; F.vcu = (F.G % 8 == 0) ? (bx % 8) * (F.G / 8) + bx / 8 : bx; }
    F.gw = F.vcu * NWAVES + F.wave; F.NGW = F.G * NWAVES;
    for (int u = F.tid; u < (LDS_BYTES - LDSCTL_OFF) / 4; u += NWAVES * 64) ((LAS unsigned*)(F.lds + LDSCTL_OFF))[u] = 0u;
    __syncthreads();
    (void)xcd_barrier_post((unsigned*)(WSP + WS_CTL) + CW_BAR, F.MISC + 8);
#define GRID_BAR() do { FRESH(a); XcdBarrier b_; b_.bar = (unsigned*)(WSP + WS_CTL) + CW_BAR; b_.x = xb_xcc_id(); b_.st = F.MISC + 8; xcd_barrier(b_); } while (0)

    FRESH(a); refresh(F); p0_prologue(a, F); GRID_BAR();

    int xcur = 0;
    for (int hl = 0; hl < 8; ++hl) {
        const int l = hl >> 1, f = hl & 1, lf = hl;
        GEMM_SITE(pg8::EpiSwiGLU, XBc, ws + WS_WGU + (size_t)lf * SZ_WGU, NGU, D, (bf16*)(ar + AR_HID), FF, SSQ + (size_t)(4 * l + 2 * f) * M);
        GRID_BAR();
        GEMM_SITE(pg8::EpiRes<0>, ar + AR_HID, ws + WS_WD + (size_t)lf * SZ_WD, D, FF, X, XBc, SSQ + (size_t)(4 * l + 2 * f + 1) * M, 0.5f, nullptr, nullptr, nullptr, nullptr);
        GRID_BAR();
        if (f == 0) {
            const int j = l >> 1;
            if ((l & 1) == 0) {
                GEMM_SITE(pg8::EpiF32, XBc, ws + WS_WIN + (size_t)j * SZ_WIN, ZP, D, (float*)(ar + AR_Z), ZP, SSQ + (size_t)(4 * l + 1) * M);
                GRID_BAR();
                FRESH(a); refresh(F); mix_pass_a(a, F, j);
                GRID_BAR();
                GEMM_SITE(pg8::EpiF32, ar + AR_A2, ws + WS_WLORA + (size_t)j * SZ_WLORA, 3072, 384, (float*)(ar + AR_L), 3072, nullptr);
                GEMM_SITE(pg8::EpiF32, ar + AR_XCB, ws + WS_WGATE + (size_t)j * SZ_WGATE, 2048, 1024, (float*)(ar + AR_GT), 2048, nullptr);
                GRID_BAR();
                FRESH(a); refresh(F); mix_pass_b(a, F, j);
                GRID_BAR();
                FRESH(a); refresh(F); scan_phase(a, F, j);
                GRID_BAR();
                FRESH(a); refresh(F); mix_pass_c(a, F, j);
                GRID_BAR();
                GEMM_SITE(pg8::EpiRes<0>, ar + AR_YMIX, ws + WS_WOUT + (size_t)j * SZ_SQ, D, D, X, XBc, SSQ + (size_t)(4 * l + 2) * M, 1.0f, nullptr, nullptr, nullptr, nullptr);
                GRID_BAR();
            } else {
                FRESH(a); refresh(F); s5_phase(a, F, j, (const bf16*)(WSP + WS_XB + (size_t)xcur * ((size_t)M * D * 2)), (const float*)(WSP + WS_SSQ) + (size_t)(4 * l + 1) * M);
                GRID_BAR();
                GEMM_SITE(pg8::EpiRes<2>, ar + AR_ZG, ws + WS_WGLU + (size_t)j * SZ_SQ, D, D, X, XBc, SSQ + (size_t)(4 * l + 2) * M, 1.0f, nullptr, nullptr, (const bf16*)(ar + AR_ZG), INP(51) + j * 2048);
                GRID_BAR();
            }
        } else {
            GEMM_SITE(pg8::EpiF32, ws + WS_PB + (size_t)l * M * 256 * 2, ws + WS_PLEP + (size_t)l * SZ_PLEP, D, 256, (float*)(ar + AR_PPT), D, nullptr);
            GEMM_SITE(pg8::EpiRes<1>, XBc, ws + WS_PLEG + (size_t)l * SZ_SQ, D, D, X, XBn, SSQ + (size_t)(4 * l + 4) * M, 1.0f, SSQ + (size_t)(4 * l + 3) * M, (const float*)(ar + AR_PPT), nullptr, nullptr);
            GRID_BAR();
            xcur ^= 1;
        }
    }
    FRESH(a); refresh(F); final_phase(a, F, (const float*)(WSP + WS_SSQ) + (size_t)16 * M);
}

extern "C" void kernel_launch(void* const* d_in, const int* in_sizes, int n_in, void* d_out, int out_size, void* d_ws, size_t ws_size, hipStream_t stream) {
    static int grid = 0;
    if (grid == 0) {
        if (n_in != 53 || out_size != (int)O_END || ws_size < WS_END) { fprintf(stderr, "kernel_launch: unexpected problem (n_in %d, out %d, ws %zu, need %zu)\n", n_in, out_size, ws_size, (size_t)WS_END); grid = -1; return; }
        int dev = 0, cus = 0, per_cu = 0;
        if (hipGetDevice(&dev) != hipSuccess || hipDeviceGetAttribute(&cus, hipDeviceAttributeMultiprocessorCount, dev) != hipSuccess) { grid = -1; return; }
        if (hipFuncSetAttribute((const void*)trunk_fwd, hipFuncAttributeMaxDynamicSharedMemorySize, LDS_BYTES) != hipSuccess) { fprintf(stderr, "kernel_launch: hipFuncSetAttribute failed\n"); grid = -1; return; }
        if (hipOccupancyMaxActiveBlocksPerMultiprocessor(&per_cu, (const void*)trunk_fwd, NWAVES * 64, LDS_BYTES) != hipSuccess || per_cu < 1) { fprintf(stderr, "kernel_launch: occupancy query says %d blocks per CU\n", per_cu); (void)hipGetLastError(); grid = -1; return; }
        grid = cus;
    }
    if (grid < 0) return;
    if (hipMemsetAsync((char*)d_ws + WS_CTL, 0, CTL_ZERO_BYTES, stream) != hipSuccess) return;
    Args a{};
    for (int i = 0; i < 53; ++i) a.in[i] = (const float*)d_in[i];
    a.out = (float*)d_out; a.ws = (unsigned char*)d_ws;
    hipLaunchKernelGGL(trunk_fwd, dim3(grid), dim3(NWAVES * 64), LDS_BYTES, stream, a);
}
```
